# Optimizing an MI355X kernel written in HIP

```python
import math
import jax, jax.numpy as jnp
from jax import lax
import numpy as np

D_MODEL = 1024
BATCH = 16
SEQ = 2048
DEPTH = 1

ATTN_HEADS = 4
HEAD_DIM = 64
V_HEAD_DIM = 2 * HEAD_DIM
ATTN_WIDTH = ATTN_HEADS * V_HEAD_DIM
QK_WIDTH = ATTN_HEADS * 2 * HEAD_DIM
ROT_DIM = HEAD_DIM // 4
ROPE_THETA = 500000.0
Q_BLOCK = 128
LAMBDA_INIT_SCALE = 0.1

SSM_WIDTH = D_MODEL // 2
SSM_GROUP = 16
SSM_GROUPS = SSM_WIDTH // SSM_GROUP
SSM_STATE = 64
DT_MIN = 1e-3
DT_MAX = 1e-1

EPS = 1e-6

IN_SIZES = (QK_WIDTH, QK_WIDTH, ATTN_WIDTH, ATTN_WIDTH, SSM_WIDTH, SSM_WIDTH, D_MODEL, D_MODEL)
IN_WIDTH = sum(IN_SIZES)
IN_OFFSETS = tuple(int(o) for o in np.cumsum(IN_SIZES)[:-1])

kernel_name = "hybrid_diffattn_s5_encoder_block"


def rmsnorm(x, g):
    xf = x.astype(jnp.float32)
    inv = lax.rsqrt(jnp.mean(xf * xf, axis=-1, keepdims=True) + EPS)
    return (xf * inv).astype(x.dtype) * g


def partial_rope(t, positions):
    half = ROT_DIM // 2
    inv_freq = ROPE_THETA ** (-jnp.arange(half, dtype=jnp.float32) * 2.0 / ROT_DIM)
    ang = positions.astype(jnp.float32)[:, :, None] * inv_freq
    cos = jnp.cos(ang)[:, :, None, None, :].astype(t.dtype)
    sin = jnp.sin(ang)[:, :, None, None, :].astype(t.dtype)
    t1 = t[..., :half]
    t2 = t[..., half:ROT_DIM]
    rest = t[..., ROT_DIM:]
    return jnp.concatenate([t1 * cos - t2 * sin, t2 * cos + t1 * sin, rest], axis=-1)


def diff_attention(q, k, v, lam):
    b, s = q.shape[0], q.shape[1]
    nblk = s // Q_BLOCK
    scale = HEAD_DIM ** -0.5
    qb = q.reshape(b, nblk, Q_BLOCK, ATTN_HEADS, 2, HEAD_DIM).transpose(1, 0, 2, 3, 4, 5)

    def block(qblk):
        sc = jnp.einsum('bqhcd,bkhcd->bhcqk', qblk, k).astype(jnp.float32) * scale
        p = jax.nn.softmax(sc, axis=-1)
        w = p[:, :, 0] - lam * p[:, :, 1]
        return jnp.einsum('bhqk,bkhe->bqhe', w.astype(v.dtype), v)

    o = lax.map(block, qb)
    return o.transpose(1, 0, 2, 3, 4).reshape(b, s, ATTN_HEADS, V_HEAD_DIM)


def s5_direction(u, lam_re, lam_im, log_dt, b_re, b_im, c_re, c_im, reverse):
    f32 = jnp.float32
    dt = jnp.exp(log_dt.astype(f32))[:, None]
    lr = jnp.minimum(lam_re.astype(f32), -1e-4)
    li = lam_im.astype(f32)
    mag = jnp.exp(lr * dt)
    ab_re = mag * jnp.cos(li * dt)
    ab_im = mag * jnp.sin(li * dt)
    den = lr * lr + li * li
    nr = ab_re - 1.0
    ni = ab_im
    coef_re = (nr * lr + ni * li) / den
    coef_im = (ni * lr - nr * li) / den
    bf_re = b_re.astype(f32)
    bf_im = b_im.astype(f32)
    bb_re = coef_re[..., None] * bf_re - coef_im[..., None] * bf_im
    bb_im = coef_re[..., None] * bf_im + coef_im[..., None] * bf_re
    uf = u.astype(f32)
    bu_re = jnp.einsum('bsgh,gph->sbgp', uf, bb_re)
    bu_im = jnp.einsum('bsgh,gph->sbgp', uf, bb_im)
    s = u.shape[1]
    a_re = jnp.broadcast_to(ab_re[None, None], (s, 1) + ab_re.shape)
    a_im = jnp.broadcast_to(ab_im[None, None], (s, 1) + ab_im.shape)

    def combine(e_i, e_j):
        ar_i, ai_i, br_i, bi_i = e_i
        ar_j, ai_j, br_j, bi_j = e_j
        return (ar_j * ar_i - ai_j * ai_i,
                ar_j * ai_i + ai_j * ar_i,
                ar_j * br_i - ai_j * bi_i + br_j,
                ar_j * bi_i + ai_j * br_i + bi_j)

    _, _, x_re, x_im = lax.associative_scan(combine, (a_re, a_im, bu_re, bu_im),
                                            reverse=reverse, axis=0)
    y = (jnp.einsum('sbgp,ghp->bsgh', x_re, c_re.astype(f32))
         - jnp.einsum('sbgp,ghp->bsgh', x_im, c_im.astype(f32)))
    return y.astype(u.dtype)


def hybrid_layer(x, c, positions, layer_idx, w_ada, b_ada, g_pre, w_in, lam_qk, g_subln,
                 lam_re, lam_im, log_dt, b_re, b_im, c_re, c_im, d_skip,
                 w_glu, b_glu, w_up_attn, w_up_ssm, w_out):
    b, s, _ = x.shape
    mod = jax.nn.silu(c) @ w_ada + b_ada
    shift, scale, gate = jnp.split(mod, 3, axis=-1)
    h = rmsnorm(x, g_pre) * (1.0 + scale[:, None, :]) + shift[:, None, :]

    proj = h @ w_in
    q, k, v, z_a, u, z_s, g_a, g_s = jnp.split(proj, IN_OFFSETS, axis=-1)

    q = partial_rope(q.reshape(b, s, ATTN_HEADS, 2, HEAD_DIM), positions)
    k = partial_rope(k.reshape(b, s, ATTN_HEADS, 2, HEAD_DIM), positions)
    v = v.reshape(b, s, ATTN_HEADS, V_HEAD_DIM)
    lam_init = 0.8 - 0.6 * math.exp(-0.3 * layer_idx)
    lf = lam_qk.astype(jnp.float32)
    lam = jnp.exp(jnp.sum(lf[0] * lf[1])) - jnp.exp(jnp.sum(lf[2] * lf[3])) + lam_init
    o = diff_attention(q, k, v, lam)
    o = rmsnorm(o, g_subln) * (1.0 - lam_init)
    attn_branch = (o.reshape(b, s, ATTN_WIDTH) * jax.nn.silu(z_a)) @ w_up_attn

    ug = u.reshape(b, s, SSM_GROUPS, SSM_GROUP)
    y = (s5_direction(ug, lam_re[0], lam_im[0], log_dt[0], b_re[0], b_im[0], c_re[0], c_im[0], False)
         + s5_direction(ug, lam_re[1], lam_im[1], log_dt[1], b_re[1], b_im[1], c_re[1], c_im[1], True))
    y = y.reshape(b, s, SSM_WIDTH) + d_skip * u
    y = jax.nn.gelu(y)
    y = y * jax.nn.sigmoid(y @ w_glu + b_glu)
    ssm_branch = (y * jax.nn.silu(z_s)) @ w_up_ssm

    merged = jax.nn.sigmoid(g_a) * attn_branch + jax.nn.sigmoid(g_s) * ssm_branch
    return x + gate[:, None, :] * (merged @ w_out)


def setup_inputs(seed: int = 0) -> dict:
    key = jax.random.key(seed)
    ks = jax.random.split(key, 24)
    L, D = DEPTH, D_MODEL
    G, P, Hg = SSM_GROUPS, SSM_STATE, SSM_GROUP
    nrm = jax.random.normal
    f32 = jnp.float32
    x = nrm(ks[0], (BATCH, SEQ, D), f32)
    c = nrm(ks[1], (BATCH, D), f32)
    positions = jnp.broadcast_to(jnp.arange(SEQ, dtype=jnp.int32)[None, :], (BATCH, SEQ))
    w_ada = nrm(ks[2], (L, D, 3 * D), f32) * D ** -0.5
    b_ada = nrm(ks[3], (L, 3 * D), f32) * 0.01
    g_pre = 1.0 + 0.02 * nrm(ks[4], (L, D), f32)
    w_in = nrm(ks[5], (L, D, IN_WIDTH), f32) * D ** -0.5
    lam_qk = nrm(ks[6], (L, 4, HEAD_DIM), f32) * LAMBDA_INIT_SCALE
    g_subln = 1.0 + 0.02 * nrm(ks[7], (L, V_HEAD_DIM), f32)
    n_idx = jnp.arange(P, dtype=f32)
    ssm_lam_re = -0.5 + 0.01 * nrm(ks[8], (L, 2, G, P), f32)
    ssm_lam_im = math.pi * n_idx + 0.01 * nrm(ks[9], (L, 2, G, P), f32)
    ssm_log_dt = jax.random.uniform(ks[10], (L, 2, G), f32, math.log(DT_MIN), math.log(DT_MAX))
    ssm_b_re = nrm(ks[11], (L, 2, G, P, Hg), f32) * (2 * Hg) ** -0.5
    ssm_b_im = nrm(ks[12], (L, 2, G, P, Hg), f32) * (2 * Hg) ** -0.5
    ssm_c_re = nrm(ks[13], (L, 2, G, Hg, P), f32) * (2 * P) ** -0.5
    ssm_c_im = nrm(ks[14], (L, 2, G, Hg, P), f32) * (2 * P) ** -0.5
    ssm_d = nrm(ks[15], (L, SSM_WIDTH), f32)
    w_glu = nrm(ks[16], (L, SSM_WIDTH, SSM_WIDTH), f32) * SSM_WIDTH ** -0.5
    b_glu = nrm(ks[17], (L, SSM_WIDTH), f32) * 0.01
    w_up_attn = nrm(ks[18], (L, ATTN_WIDTH, D), f32) * ATTN_WIDTH ** -0.5
    w_up_ssm = nrm(ks[19], (L, SSM_WIDTH, D), f32) * SSM_WIDTH ** -0.5
    w_out = nrm(ks[20], (L, D, D), f32) * D ** -0.5
    g_final = 1.0 + 0.02 * nrm(ks[21], (D,), f32)
    return {"x": x, "c": c, "positions": positions, "w_ada": w_ada, "b_ada": b_ada,
            "g_pre": g_pre, "w_in": w_in, "lam_qk": lam_qk, "g_subln": g_subln,
            "ssm_lam_re": ssm_lam_re, "ssm_lam_im": ssm_lam_im, "ssm_log_dt": ssm_log_dt,
            "ssm_b_re": ssm_b_re, "ssm_b_im": ssm_b_im, "ssm_c_re": ssm_c_re, "ssm_c_im": ssm_c_im,
            "ssm_d": ssm_d, "w_glu": w_glu, "b_glu": b_glu, "w_up_attn": w_up_attn,
            "w_up_ssm": w_up_ssm, "w_out": w_out, "g_final": g_final}


def reference(x, c, positions, w_ada, b_ada, g_pre, w_in, lam_qk, g_subln,
              ssm_lam_re, ssm_lam_im, ssm_log_dt, ssm_b_re, ssm_b_im, ssm_c_re, ssm_c_im,
              ssm_d, w_glu, b_glu, w_up_attn, w_up_ssm, w_out, g_final):
    for l in range(DEPTH):
        x = hybrid_layer(x, c, positions, l, w_ada[l], b_ada[l], g_pre[l], w_in[l], lam_qk[l],
                         g_subln[l], ssm_lam_re[l], ssm_lam_im[l], ssm_log_dt[l],
                         ssm_b_re[l], ssm_b_im[l], ssm_c_re[l], ssm_c_im[l], ssm_d[l],
                         w_glu[l], b_glu[l], w_up_attn[l], w_up_ssm[l], w_out[l])
    return rmsnorm(x, g_final)
```

```cpp
#include <hip/hip_runtime.h>
#include <cstdio>
#include <cstdint>
namespace pg8 {
#define PG8_LAS __attribute__((address_space(3)))
typedef unsigned short bf16_t;
typedef short bf16x8 __attribute__((ext_vector_type(8)));
typedef float f32x4 __attribute__((ext_vector_type(4)));
typedef unsigned u32x4 __attribute__((ext_vector_type(4)));
constexpr int BM = 256, BK = 64, HALF = 128, HTB = HALF * BK * 2  , STAGE_BYTES = 8 * HTB, NXCD = 8, WGM = 8;

__host__ __device__ __forceinline__ int lds_byte(int r, int c) { const int st = (r >> 4) * 2 + (c >> 5), rr = r & 15, cc = c & 31, ob = rr * 64 + cc * 2; return st * 1024 + (ob ^ (((ob >> 9) & 1) << 5)); }
__host__ __device__ __forceinline__ void stage_rc(int b, int& R, int& C) { const int st = b / 1024, sb = b % 1024, swz = sb ^ (((sb >> 9) & 1) << 5); R = (st >> 1) * 16 + swz / 64; C = (st & 1) * 32 + (swz % 64) / 2; }
__host__ __device__ __forceinline__ int perm32(int rho) { const int n = rho >> 4, i = rho & 15; return 8 * (i >> 2) + 4 * n + (i & 3); }

struct Unit { int pm, pn; };
struct Gemm { const bf16_t* A; const bf16_t* Bt; int M, N, K; };

struct StaticOrder {
    int nM, nN, nwg, G, c;
    __host__ __device__ void init(int M, int N, int G_, int c_) { nM = M / BM; nN = N / BM; nwg = nM * nN; G = G_; c = c_; }
    __host__ __device__ bool next(int i, Unit& u) const {
        const long L = (long)i * G + c; if (L >= nwg) return false;
        int wgid = (int)L; { const int q = nwg / NXCD, r = nwg % NXCD, xcd = wgid % NXCD, off = wgid / NXCD; wgid = (xcd < r ? xcd * (q + 1) : r * (q + 1) + (xcd - r) * q) + off; }
        const int nig = WGM * nN, gid = wgid / nig, fm = gid * WGM, gsz = (nM - fm) < WGM ? (nM - fm) : WGM;
        u.pm = fm + ((wgid % nig) % gsz); u.pn = (wgid % nig) / gsz; return true;
    }
    __device__ __forceinline__ void a_ready(const Unit&) const {}
    __device__ __forceinline__ void done(const Unit&) const {}
};

__device__ __forceinline__ unsigned cvt_pk_bf16(float lo, float hi) { unsigned r; asm volatile("v_cvt_pk_bf16_f32 %0, %1, %2" : "=v"(r) : "v"(lo), "v"(hi)); return r; }
__device__ __forceinline__ float bf_lo(unsigned w) { return __uint_as_float(w << 16); }
__device__ __forceinline__ float bf_hi(unsigned w) { return __uint_as_float(w & 0xffff0000u); }
__device__ __forceinline__ float sigmoid_f(float x) { return __builtin_amdgcn_rcpf(1.0f + __builtin_amdgcn_exp2f(-1.4426950408889634f * x)); }
__device__ __forceinline__ void unpack8(const u32x4 w, float (&f)[8]) { f[0] = bf_lo(w.x); f[1] = bf_hi(w.x); f[2] = bf_lo(w.y); f[3] = bf_hi(w.y); f[4] = bf_lo(w.z); f[5] = bf_hi(w.z); f[6] = bf_lo(w.w); f[7] = bf_hi(w.w); }
__device__ __forceinline__ u32x4 pack8(const float (&f)[8]) { u32x4 w; w.x = cvt_pk_bf16(f[0], f[1]); w.y = cvt_pk_bf16(f[2], f[3]); w.z = cvt_pk_bf16(f[4], f[5]); w.w = cvt_pk_bf16(f[6], f[7]); return w; }

struct EpiProj {
    static constexpr bool PERM = true, AFTER_DRAIN = false;
    bf16_t *QKV, *ZA, *U, *ZS, *GA, *GS; const float* rope; float qscale;
    __device__ __forceinline__ void operator()(const f32x4 (&acc)[2][2][4][2], const Unit& u, int wr, int wc, int fr, int fq) const {
        const int pn = u.pn; bf16_t* base; int ldc, colt, act;
        float sc = 1.f;
        if (pn < 2)       { base = QKV; ldc = 1536; colt = pn * 256; act = 3; sc = qscale; }
        else if (pn < 4)  { base = QKV; ldc = 1536; colt = 512 + (pn - 2) * 256; act = 3; }
        else if (pn < 6)  { base = QKV; ldc = 1536; colt = 1024 + (pn - 4) * 256; act = 0; }
        else if (pn < 8)  { base = ZA; ldc = 512; colt = (pn - 6) * 256; act = 1; }
        else if (pn < 10) { base = U;  ldc = 512; colt = (pn - 8) * 256; act = 0; }
        else if (pn < 12) { base = ZS; ldc = 512; colt = (pn - 10) * 256; act = 1; }
        else if (pn < 16) { base = GA; ldc = 1024; colt = (pn - 12) * 256; act = 2; }
        else              { base = GS; ldc = 1024; colt = (pn - 16) * 256; act = 2; }
        const int row0 = u.pm * BM + wr * 64 + fr, col0 = colt + wc * 32 + 8 * fq;
        const bool rotw = (act == 3) && ((wc & 1) == 0);
#pragma unroll
        for (int ai = 0; ai < 2; ++ai)
#pragma unroll
            for (int m = 0; m < 4; ++m) {
                const int row = row0 + ai * HALF + m * 16; bf16_t* rowp = base + (size_t)row * ldc + col0;
                float cs[8], sn[8];
                if (rotw) { const f32x4* rp = (const f32x4*)(rope + (size_t)row * 16); const f32x4 c0 = rp[0], c1 = rp[1], s0 = rp[2], s1 = rp[3];
                    cs[0] = c0[0]; cs[1] = c0[1]; cs[2] = c0[2]; cs[3] = c0[3]; cs[4] = c1[0]; cs[5] = c1[1]; cs[6] = c1[2]; cs[7] = c1[3];
                    sn[0] = s0[0]; sn[1] = s0[1]; sn[2] = s0[2]; sn[3] = s0[3]; sn[4] = s1[0]; sn[5] = s1[1]; sn[6] = s1[2]; sn[7] = s1[3]; }
#pragma unroll
                for (int bj = 0; bj < 2; ++bj) {
                    float v[8];
#pragma unroll
                    for (int e = 0; e < 4; ++e) { v[e] = acc[ai][bj][m][0][e]; v[4 + e] = acc[ai][bj][m][1][e]; }
                    if (act == 1) {
#pragma unroll
                        for (int e = 0; e < 8; ++e) v[e] = v[e] * sigmoid_f(v[e]);
                    } else if (act == 2) {
#pragma unroll
                        for (int e = 0; e < 8; ++e) v[e] = sigmoid_f(v[e]);
                    } else if (act == 3) {
                        if (rotw) {
#pragma unroll
                            for (int e = 0; e < 8; ++e) { const float o = __shfl_xor(v[e], 16);
                                const float r1 = v[e] * cs[e] - o * sn[e], r2 = v[e] * cs[e] + o * sn[e];
                                v[e] = (fq == 0) ? r1 : ((fq == 1) ? r2 : v[e]); }
                        }
#pragma unroll
                        for (int e = 0; e < 8; ++e) v[e] *= sc;
                    }
                    *(u32x4*)(rowp + bj * HALF) = pack8(v);
                }
            }
    }
};
struct EpiGlu {
    static constexpr bool PERM = true, AFTER_DRAIN = false;
    const bf16_t *Y, *ZS; bf16_t* Y2; const float* bias;
    __device__ __forceinline__ void operator()(const f32x4 (&acc)[2][2][4][2], const Unit& u, int wr, int wc, int fr, int fq) const {
        const int row0 = u.pm * BM + wr * 64 + fr, col0 = u.pn * BM + wc * 32 + 8 * fq;
#pragma unroll
        for (int ai = 0; ai < 2; ++ai)
#pragma unroll
            for (int m = 0; m < 4; ++m) { const size_t off = (size_t)(row0 + ai * HALF + m * 16) * 512 + col0;
#pragma unroll
                for (int bj = 0; bj < 2; ++bj) {
                    const f32x4 b0 = *(const f32x4*)(bias + col0 + bj * HALF), b1 = *(const f32x4*)(bias + col0 + bj * HALF + 4);
                    float yv[8], zv[8], v[8]; unpack8(*(const u32x4*)(Y + off + bj * HALF), yv); unpack8(*(const u32x4*)(ZS + off + bj * HALF), zv);
#pragma unroll
                    for (int e = 0; e < 4; ++e) { v[e] = yv[e] * sigmoid_f(acc[ai][bj][m][0][e] + b0[e]) * zv[e]; v[4 + e] = yv[4 + e] * sigmoid_f(acc[ai][bj][m][1][e] + b1[e]) * zv[4 + e]; }
                    *(u32x4*)(Y2 + off + bj * HALF) = pack8(v);
                } }
    }
};
template <int MODE> struct EpiMerge {
    static constexpr bool PERM = true, AFTER_DRAIN = false;
    bf16_t* G; const bf16_t* G2;
    __device__ __forceinline__ void operator()(const f32x4 (&acc)[2][2][4][2], const Unit& u, int wr, int wc, int fr, int fq) const {
        const int row0 = u.pm * BM + wr * 64 + fr, col0 = u.pn * BM + wc * 32 + 8 * fq;
#pragma unroll
        for (int ai = 0; ai < 2; ++ai)
#pragma unroll
            for (int m = 0; m < 4; ++m) { const size_t off = (size_t)(row0 + ai * HALF + m * 16) * 1024 + col0;
#pragma unroll
                for (int bj = 0; bj < 2; ++bj) {
                    float g[8], v[8]; unpack8(*(const u32x4*)(G + off + bj * HALF), g);
                    if (MODE == 0) {
#pragma unroll
                        for (int e = 0; e < 4; ++e) { v[e] = g[e] * acc[ai][bj][m][0][e]; v[4 + e] = g[4 + e] * acc[ai][bj][m][1][e]; }
                    } else { float g2[8]; unpack8(*(const u32x4*)(G2 + off + bj * HALF), g2);
#pragma unroll
                        for (int e = 0; e < 4; ++e) { v[e] = g[e] + g2[e] * acc[ai][bj][m][0][e]; v[4 + e] = g[4 + e] + g2[4 + e] * acc[ai][bj][m][1][e]; }
                    }
                    *(u32x4*)(G + off + bj * HALF) = pack8(v);
                } }
    }
};
struct EpiOut {
    static constexpr bool PERM = true, AFTER_DRAIN = false;
    const float* x; const float* gate; float* out; float* rowss;
    __device__ __forceinline__ void operator()(const f32x4 (&acc)[2][2][4][2], const Unit& u, int wr, int wc, int fr, int fq) const {
        const int row0 = u.pm * BM + wr * 64 + fr, col0 = u.pn * BM + wc * 32 + 8 * fq;
        const float* gb = gate + (size_t)((u.pm * BM) >> 11) * 1024;
        f32x4 g[2][2];
#pragma unroll
        for (int bj = 0; bj < 2; ++bj) { g[bj][0] = *(const f32x4*)(gb + col0 + bj * HALF); g[bj][1] = *(const f32x4*)(gb + col0 + bj * HALF + 4); }
#pragma unroll
        for (int ai = 0; ai < 2; ++ai)
#pragma unroll
            for (int m = 0; m < 4; ++m) { const int row = row0 + ai * HALF + m * 16; const size_t off = (size_t)row * 1024 + col0; float ss = 0.f;
#pragma unroll
                for (int bj = 0; bj < 2; ++bj)
#pragma unroll
                    for (int n = 0; n < 2; ++n) { const f32x4 xv = *(const f32x4*)(x + off + bj * HALF + 4 * n); const f32x4 o = xv + g[bj][n] * acc[ai][bj][m][n];
                        *(f32x4*)(out + off + bj * HALF + 4 * n) = o; ss += (o[0] * o[0] + o[1] * o[1]) + (o[2] * o[2] + o[3] * o[3]); }
                ss += __shfl_xor(ss, 16); ss += __shfl_xor(ss, 32);
                if (fq == 0) atomicAdd(rowss + row, ss); }
    }
};

template <class Epi, class Sched, bool ALIGN_EPI = false, bool SP2 = false>
__device__ __forceinline__ void gemm_phase(PG8_LAS unsigned char* lds, const Gemm g, const Sched& S, const Epi& E) {
    const int tid = threadIdx.x, wid = __builtin_amdgcn_readfirstlane(tid >> 6), lane = tid & 63, wr = wid >> 2, wc = wid & 3, fr = lane & 15, fq = lane >> 4;
    const int K = g.K, nt = K / BK;
    unsigned voffA[2], voffB[2];
#pragma unroll
    for (int i = 0; i < 2; ++i) { int R, C; stage_rc(tid * 16 + i * 8192, R, C); const int Rb = Epi::PERM ? ((R & ~31) + perm32(R & 31)) : R;
        voffA[i] = (unsigned)(R * K + C) * 2u; voffB[i] = (unsigned)(Rb * K + C) * 2u; }
    const size_t kstep = (size_t)(BK * 2);
    const size_t hstep = (size_t)HALF * K * 2;
    const size_t tstep = 2 * hstep;
    const unsigned ldsw = (unsigned)wid * 1024u;
    const int aoff = lds_byte(wr * 64 + fr, fq * 8), boff = lds_byte(wc * 32 + fr, fq * 8);
#define PG8_SA(b, h) (((b) * 2 + (h)) * HTB)
#define PG8_SB(b, h) ((4 + (b) * 2 + (h)) * HTB)
#define PG8_STAGE(bufoff, gbase, voff) do { _Pragma("unroll") for (int _i = 0; _i < 2; ++_i) \
        __builtin_amdgcn_global_load_lds((const unsigned*)((const char*)(gbase) + (voff)[_i]), (PG8_LAS unsigned*)(lds + (bufoff) + ldsw + _i * 8192), 16, 0, 0); } while (0)
#define PG8_LDA(dst, b, h) do { _Pragma("unroll") for (int m = 0; m < 4; ++m) _Pragma("unroll") for (int k = 0; k < 2; ++k) dst[m][k] = *(const PG8_LAS bf16x8*)(lds + PG8_SA(b, h) + aoff + m * 2048 + k * 1024); } while (0)
#define PG8_LDB(dst, b, h) do { _Pragma("unroll") for (int n = 0; n < 2; ++n) _Pragma("unroll") for (int k = 0; k < 2; ++k) dst[n][k] = *(const PG8_LAS bf16x8*)(lds + PG8_SB(b, h) + boff + n * 2048 + k * 1024); } while (0)
#define PG8_MMA(ai, bj, At, Bt) do { __builtin_amdgcn_s_setprio(1); _Pragma("unroll") for (int m = 0; m < 4; ++m) _Pragma("unroll") for (int n = 0; n < 2; ++n) _Pragma("unroll") for (int k = 0; k < 2; ++k) \
        acc[ai][bj][m][n] = __builtin_amdgcn_mfma_f32_16x16x32_bf16(Bt[n][k], At[m][k], acc[ai][bj][m][n], 0, 0, 0); __builtin_amdgcn_s_setprio(0); } while (0)
#define PG8_WAIT_V(n) asm volatile("s_waitcnt vmcnt(" #n ")" ::: "memory")
#define PG8_WAIT_L(n) asm volatile("s_waitcnt lgkmcnt(" #n ")" ::: "memory")
#define PG8_BAR __builtin_amdgcn_s_barrier()
#define PG8_SCHED __builtin_amdgcn_sched_barrier(0)
    Unit cur, nxt; int ui = 0;
    if (!S.next(0, cur)) return;
    f32x4 acc[2][2][4][2];
#pragma unroll
    for (int a = 0; a < 2; ++a)
#pragma unroll
        for (int b = 0; b < 2; ++b)
#pragma unroll
            for (int m = 0; m < 4; ++m)
#pragma unroll
                for (int n = 0; n < 2; ++n) acc[a][b][m][n] = (f32x4){0.f, 0.f, 0.f, 0.f};
    bf16x8 At[4][2], B0[2][2], B1[2][2];
    const char* cA = (const char*)g.A + (size_t)cur.pm * tstep; const char* cB = (const char*)g.Bt + (size_t)cur.pn * tstep;
    S.a_ready(cur);
    if constexpr (SP2) {
        PG8_STAGE(PG8_SB(0, 0), cB, voffB); PG8_STAGE(PG8_SB(0, 1), cB + hstep, voffB); PG8_STAGE(PG8_SA(0, 0), cA, voffA); PG8_STAGE(PG8_SA(0, 1), cA + hstep, voffA);
        if (wr == 1) PG8_BAR;
        PG8_WAIT_V(2); PG8_BAR;
        PG8_STAGE(PG8_SB(1, 0), cB + kstep, voffB); PG8_STAGE(PG8_SA(1, 0), cA + kstep, voffA); PG8_STAGE(PG8_SB(1, 1), cB + hstep + kstep, voffB);
        PG8_WAIT_V(6); PG8_BAR;
    } else {
        PG8_STAGE(PG8_SB(0, 0), cB, voffB); PG8_STAGE(PG8_SA(0, 0), cA, voffA); PG8_STAGE(PG8_SB(0, 1), cB + hstep, voffB); PG8_STAGE(PG8_SA(0, 1), cA + hstep, voffA);
        if (wr == 1) PG8_BAR;
        PG8_WAIT_V(4); PG8_BAR;
        PG8_STAGE(PG8_SB(1, 0), cB + kstep, voffB); PG8_STAGE(PG8_SA(1, 0), cA + kstep, voffA); PG8_STAGE(PG8_SB(1, 1), cB + hstep + kstep, voffB);
        PG8_WAIT_V(6); PG8_BAR;
    }
    for (;;) {
        const bool has_next = S.next(ui + 1, nxt);
        const char* nA = has_next ? (const char*)g.A + (size_t)nxt.pm * tstep : cA; const char* nB = has_next ? (const char*)g.Bt + (size_t)nxt.pn * tstep : cB;
        for (int t = 0; t < nt; t += 2) {
            const bool last = (t == nt - 2);
            const char* a1 = cA + (size_t)(t + 1) * kstep;
            const char* a2 = last ? nA : cA + (size_t)(t + 2) * kstep; const char* b2 = last ? nB : cB + (size_t)(t + 2) * kstep;
            const char* a3 = a2 + kstep; const char* b3 = b2 + kstep;
            if (last && has_next) S.a_ready(nxt);
            if constexpr (SP2) {
            PG8_LDB(B0, 0, 0); PG8_LDB(B1, 0, 1); PG8_SCHED; PG8_LDA(At, 0, 0); PG8_STAGE(PG8_SA(1, 1), a1 + hstep, voffA);
            PG8_WAIT_V(8); PG8_WAIT_L(0); PG8_BAR; PG8_MMA(0, 0, At, B0); PG8_MMA(0, 1, At, B1); PG8_BAR; PG8_SCHED;
            PG8_LDA(At, 0, 1); PG8_STAGE(PG8_SB(0, 0), b2, voffB); PG8_STAGE(PG8_SB(0, 1), b2 + hstep, voffB); PG8_STAGE(PG8_SA(0, 0), a2, voffA);
            PG8_WAIT_V(8); PG8_WAIT_L(0); PG8_BAR; PG8_MMA(1, 0, At, B0); PG8_MMA(1, 1, At, B1); PG8_BAR; PG8_SCHED;
            PG8_LDB(B0, 1, 0); PG8_LDB(B1, 1, 1); PG8_SCHED; PG8_LDA(At, 1, 0); PG8_STAGE(PG8_SA(0, 1), a2 + hstep, voffA);
            PG8_WAIT_V(8); PG8_WAIT_L(0); PG8_BAR; PG8_MMA(0, 0, At, B0); PG8_MMA(0, 1, At, B1); PG8_BAR; PG8_SCHED;
            PG8_LDA(At, 1, 1); PG8_STAGE(PG8_SB(1, 0), b3, voffB); PG8_STAGE(PG8_SB(1, 1), b3 + hstep, voffB); PG8_STAGE(PG8_SA(1, 0), a3, voffA);
            PG8_WAIT_V(8); PG8_WAIT_L(0); PG8_BAR; PG8_MMA(1, 0, At, B0); PG8_MMA(1, 1, At, B1); PG8_BAR; PG8_SCHED;
            } else {
            PG8_LDB(B0, 0, 0); PG8_SCHED; PG8_LDA(At, 0, 0); PG8_STAGE(PG8_SA(1, 1), a1 + hstep, voffA);
            PG8_WAIT_L(8); PG8_BAR; PG8_WAIT_L(0); PG8_MMA(0, 0, At, B0); PG8_BAR; PG8_SCHED;
            PG8_LDB(B1, 0, 1); PG8_STAGE(PG8_SB(0, 0), b2, voffB);
            PG8_BAR; PG8_WAIT_L(0); PG8_MMA(0, 1, At, B1); PG8_BAR;
            PG8_LDA(At, 0, 1); PG8_STAGE(PG8_SA(0, 0), a2, voffA);
            PG8_BAR; PG8_WAIT_L(0); PG8_MMA(1, 0, At, B0); PG8_BAR; PG8_SCHED;
            PG8_STAGE(PG8_SB(0, 1), b2 + hstep, voffB);
            PG8_WAIT_V(6); PG8_BAR; PG8_MMA(1, 1, At, B1); PG8_BAR;
            PG8_LDB(B0, 1, 0); PG8_SCHED; PG8_LDA(At, 1, 0); PG8_STAGE(PG8_SA(0, 1), a2 + hstep, voffA);
            PG8_WAIT_L(8); PG8_BAR; PG8_WAIT_L(0); PG8_MMA(0, 0, At, B0); PG8_BAR; PG8_SCHED;
            PG8_LDB(B1, 1, 1); PG8_STAGE(PG8_SB(1, 0), b3, voffB);
            PG8_BAR; PG8_WAIT_L(0); PG8_MMA(0, 1, At, B1); PG8_BAR;
            PG8_LDA(At, 1, 1); PG8_STAGE(PG8_SA(1, 0), a3, voffA);
            PG8_BAR; PG8_WAIT_L(0); PG8_MMA(1, 0, At, B0); PG8_BAR; PG8_SCHED;
            PG8_STAGE(PG8_SB(1, 1), b3 + hstep, voffB);
            PG8_WAIT_V(6); PG8_BAR; PG8_MMA(1, 1, At, B1); PG8_BAR;
            }
        }
        if constexpr (ALIGN_EPI) { if (wr == 0) PG8_BAR; }
        if constexpr (!Epi::AFTER_DRAIN) { E(acc, cur, wr, wc, fr, fq); S.done(cur); }
        if (!has_next) break;
#pragma unroll
        for (int a = 0; a < 2; ++a)
#pragma unroll
            for (int b = 0; b < 2; ++b)
#pragma unroll
                for (int m = 0; m < 4; ++m)
#pragma unroll
                    for (int n = 0; n < 2; ++n) acc[a][b][m][n] = (f32x4){0.f, 0.f, 0.f, 0.f};
        cur = nxt; cA = nA; cB = nB; ++ui;
        if constexpr (ALIGN_EPI) { if (wr == 1) PG8_BAR; }
    }
    PG8_WAIT_V(0);
    if constexpr (!ALIGN_EPI) { if (wr == 0) PG8_BAR; }
    PG8_BAR;
    if constexpr (Epi::AFTER_DRAIN) { E.fused(acc, cur, wr, wc, fr, fq, lds, wid, lane); S.done(cur); }
#undef PG8_SA
#undef PG8_SB
#undef PG8_STAGE
#undef PG8_LDA
#undef PG8_LDB
#undef PG8_MMA
#undef PG8_WAIT_V
#undef PG8_WAIT_L
#undef PG8_BAR
#undef PG8_SCHED
}
}
#define GAS __attribute__((address_space(1)))
#define LAS __attribute__((address_space(3)))
typedef unsigned short bf16;
typedef unsigned v4u __attribute__((ext_vector_type(4)));
typedef float f32x4 __attribute__((ext_vector_type(4)));
typedef short bf16x8 __attribute__((ext_vector_type(8)));
typedef GAS unsigned gu32;
typedef GAS unsigned long long gu64;
#define RLX_AGENT __ATOMIC_RELAXED, __HIP_MEMORY_SCOPE_AGENT
#define LDS_WAIT() asm volatile("s_waitcnt lgkmcnt(0)" ::: "memory")
#define VM_WAIT() asm volatile("s_waitcnt vmcnt(0)" ::: "memory")
__device__ __forceinline__ unsigned long long rt() { return __builtin_amdgcn_s_memrealtime(); }
__device__ __forceinline__ unsigned f2bf(float f) { unsigned u = __builtin_bit_cast(unsigned, f); return (u + 0x7fffu + ((u >> 16) & 1u)) >> 16; }
__device__ __forceinline__ unsigned pk2(float lo, float hi) { return f2bf(lo) | (f2bf(hi) << 16); }

#define XB_TMO      128
#define XB_XCNT(j)  (256  + 64 * (j))
#define XB_XSUB(j)  (1280 + 64 * (j))
#define XB_XGEN(j)  (2304 + 64 * (j))
#define XB_TOP      3328
#define XB_TOPGEN   3392
#define XCD_BAR_WORDS 3456
#define XB_SPIN_CAP (1u << 18)

__device__ __forceinline__ unsigned xb_ld(unsigned* p)              { return __hip_atomic_load(p, __ATOMIC_RELAXED, __HIP_MEMORY_SCOPE_AGENT); }
__device__ __forceinline__ unsigned xb_add(unsigned* p, unsigned v) { return __hip_atomic_fetch_add(p, v, __ATOMIC_RELAXED, __HIP_MEMORY_SCOPE_AGENT); }
__device__ __forceinline__ unsigned xb_xcc_id() { return (unsigned)__builtin_amdgcn_s_getreg((3 << 11) | 20) & 0xFu; }
#define XB_SPIN(cond, bar) do { unsigned _sp = 0; while (cond) { __builtin_amdgcn_s_sleep(1); \
    if ((++_sp & 255u) == 0u) { if (xb_ld(&(bar)[XB_TMO])) break; if (_sp > XB_SPIN_CAP) { atomicAdd(&(bar)[XB_TMO], 1u); break; } } } } while (0)

struct XcdBarrier {
    unsigned* bar; unsigned x;
    volatile LAS unsigned* st;
};

__device__ __forceinline__ XcdBarrier xcd_barrier_post(unsigned* bar, volatile LAS unsigned* st) {
    XcdBarrier b; b.bar = bar; b.x = xb_xcc_id(); b.st = st;
    if (threadIdx.x == 0) (void)xb_add(&bar[XB_XCNT(b.x)], 1u);
    return b;
}
__device__ __forceinline__ void xcd_barrier_complete(unsigned* bar, unsigned x, unsigned& nloc, unsigned& nx) {
    const unsigned G = gridDim.x * gridDim.y * gridDim.z;
    unsigned sum, cnt, mine, sp = 0u;
    for (;;) {
        sum = 0u; cnt = 0u; mine = 0u;
#pragma unroll
        for (unsigned j = 0; j < 16; ++j) { const unsigned c = xb_ld(&bar[XB_XCNT(j)]); sum += c; cnt += (c > 0u) ? 1u : 0u; mine = (j == x) ? c : mine; }
        if (sum == G) break;
        __builtin_amdgcn_s_sleep(1);
        if ((++sp & 255u) == 0u) { if (xb_ld(&bar[XB_TMO])) break; if (sp > XB_SPIN_CAP) { atomicAdd(&bar[XB_TMO], 1u); break; } }
    }
    nloc = mine > 0u ? mine : 1u; nx = cnt > 0u ? cnt : 1u;
}

__device__ __forceinline__ void xcd_barrier(const XcdBarrier& b) {
    asm volatile("s_waitcnt vmcnt(0)" ::: "memory");
    __syncthreads();
    if (threadIdx.x == 0) {
        unsigned* bar = b.bar;
        __builtin_amdgcn_s_waitcnt(0);
        unsigned nloc = b.st[0], nx = b.st[1];
        if (nloc == 0u) { xcd_barrier_complete(bar, b.x, nloc, nx); b.st[0] = nloc; b.st[1] = nx; }
        const unsigned old = xb_add(&bar[XB_XSUB(b.x)], 1u);
        const unsigned gen = old / nloc;
        if (old + 1u == (gen + 1u) * nloc) {
            __builtin_amdgcn_fence(__ATOMIC_RELEASE, "agent");
            asm volatile("s_waitcnt vmcnt(0)" ::: "memory");
            const unsigned og = xb_add(&bar[XB_TOP], 1u);
            const unsigned tg = og / nx;
            if (og + 1u == (tg + 1u) * nx) xb_add(&bar[XB_TOPGEN], 1u);
            else XB_SPIN(xb_ld(&bar[XB_TOPGEN]) == tg, bar);
            __builtin_amdgcn_fence(__ATOMIC_ACQUIRE, "agent");
            xb_add(&bar[XB_XGEN(b.x)], 1u);
            asm volatile("s_waitcnt vmcnt(0)" ::: "memory");
        } else {
            XB_SPIN(xb_ld(&bar[XB_XGEN(b.x)]) == gen, bar);
            __builtin_amdgcn_fence(__ATOMIC_ACQUIRE, "agent");
            asm volatile("s_waitcnt vmcnt(0)" ::: "memory");
        }
    }
    __syncthreads();
}
constexpr int NWAVES = 8;
constexpr int NB = 16, SEQ = 2048, DM = 1024, M = NB * SEQ;
constexpr int NPROJ = 5120, QKVW = 1536;
constexpr int NH = 4, HD = 64, VD = 128;
constexpr int SSMW = 512, NG = 32, GH = 16, NP = 64;
constexpr float EPS = 1e-6f, LOG2E = 1.4426950408889634f, QSCALE = 0.125f * LOG2E;
constexpr float LAM_INIT = 0.2f;
constexpr int KSL = 8;

constexpr size_t MiB = 1u << 20;
constexpr size_t WS_CTL = 0, CTL_ZERO_BYTES = 1 * MiB;
constexpr size_t WS_MODP = 1 * MiB;
constexpr size_t WS_GATE = 3 * MiB;
constexpr size_t WS_ROPE = 4 * MiB;
constexpr size_t WS_WIN = 6 * MiB, WS_WGLU = 16 * MiB, WS_WUPA = 17 * MiB, WS_WUPS = 18 * MiB, WS_WOUT = 19 * MiB;
constexpr size_t WS_SSMT = 22 * MiB;
constexpr size_t WS_H = 40 * MiB;
constexpr size_t WS_AIN = 40 * MiB, WS_Y = 72 * MiB;
constexpr size_t WS_QKV = 104 * MiB;
constexpr size_t WS_ZA = 200 * MiB, WS_U = 232 * MiB, WS_ZS = 264 * MiB;
constexpr size_t WS_Y2 = WS_U;
constexpr size_t WS_GA = 296 * MiB, WS_GS = 360 * MiB;
constexpr size_t WS_YTMP = 424 * MiB;
constexpr size_t WS_END = 488 * MiB;
constexpr int CW_TMO = 0, CW_BAR = 4096, CW_ROWSS = 65536;
static_assert((CW_ROWSS + M) * 4 <= (int)CTL_ZERO_BYTES, "ctl");

constexpr int RING_OFF = 0, RING_BYTES = 131072;
constexpr int LDSCTL_OFF = RING_BYTES, MISC_OFF = LDSCTL_OFF + 320;
constexpr int LDS_BYTES = 147456;
struct Frame {
    LAS unsigned char* lds;
    volatile LAS unsigned* MISC;
    gu32* ctl;
    int tid, lane, wave;
    int vcu, G;
    const float* in[23]; float* out; unsigned char* ws;
};
__device__ __forceinline__ float wave_sum(float v) {
#pragma unroll
    for (int o = 1; o < 64; o <<= 1) v += __shfl_xor(v, o);
    return v;
}
__device__ __forceinline__ float sigm(float x) { return __builtin_amdgcn_rcpf(1.0f + __builtin_amdgcn_exp2f(-LOG2E * x)); }
__device__ __forceinline__ float bflo(unsigned w) { return __uint_as_float(w << 16); }
__device__ __forceinline__ float bfhi(unsigned w) { return __uint_as_float(w & 0xffff0000u); }
__device__ __forceinline__ float sin_rev(float ang) { float r = ang * 0.15915494309189535f; r -= floorf(r); return __builtin_amdgcn_sinf(r); }
__device__ __forceinline__ float cos_rev(float ang) { float r = ang * 0.15915494309189535f; r -= floorf(r); return __builtin_amdgcn_cosf(r); }

__device__ __forceinline__ void p0_transpose_item(const float* W, int K, int N, bf16* WT, LAS float* scr, int item, int lane) {
    const int nblk = N / 32, kb = item / nblk, nb = item % nblk, k0 = 64 * kb, n0 = 32 * nb;
#pragma unroll 8
    for (int i = 0; i < 32; ++i) { const int kk = 2 * i + (lane >> 5); scr[kk * 33 + (lane & 31)] = W[(size_t)(k0 + kk) * N + n0 + (lane & 31)]; }
    LDS_WAIT(); asm volatile("" ::: "memory");
    const int c = lane & 7;
#pragma unroll
    for (int j = 0; j < 4; ++j) { const int n = (lane >> 3) + 8 * j; const LAS float* s = scr + (8 * c) * 33 + n;
        v4u o; o.x = pk2(s[0 * 33], s[1 * 33]); o.y = pk2(s[2 * 33], s[3 * 33]); o.z = pk2(s[4 * 33], s[5 * 33]); o.w = pk2(s[6 * 33], s[7 * 33]);
        *(GAS v4u*)(WT + (size_t)(n0 + n) * K + k0 + 8 * c) = o; }
    LDS_WAIT(); asm volatile("" ::: "memory");
}
__device__ __forceinline__ void p0_prologue(Frame& F) {
    LAS float* scr = (LAS float*)(F.lds + RING_OFF + F.wave * 16384);
    const int gw = F.vcu * NWAVES + F.wave, NGW = F.G * NWAVES;
    constexpr int I_IN = (DM / 64) * (NPROJ / 32), I_GLU = (512 / 64) * (512 / 32), I_UP = (512 / 64) * (DM / 32), I_OUT = (DM / 64) * (DM / 32);
    constexpr int I_MOD = 48 * KSL;
    constexpr int NITEMS = I_IN + I_GLU + 2 * I_UP + I_OUT + I_MOD;
    bf16* ws16 = (bf16*)F.ws;
    for (int it = gw; it < NITEMS; it += NGW) {
        int r = it;
        if (r < I_MOD) {
            const int cg = r / KSL, ks = r % KSL, n = cg * 64 + F.lane, k0 = ks * 128;
            const float* c = F.in[1]; const float* wa = F.in[3];
            for (int i = F.lane; i < 16 * 128; i += 64) { const int b = i >> 7, k = i & 127; const float cv = c[b * DM + k0 + k]; scr[i] = cv * sigm(cv); }
            LDS_WAIT(); asm volatile("" ::: "memory");
            float acc[16];
#pragma unroll
            for (int b = 0; b < 16; ++b) acc[b] = 0.f;
            for (int k = 0; k < 128; ++k) { const float w = wa[(size_t)(k0 + k) * 3072 + n];
#pragma unroll
                for (int b = 0; b < 16; ++b) acc[b] += scr[b * 128 + k] * w; }
            float* mp = (float*)(F.ws + WS_MODP) + (size_t)ks * 16 * 3072;
#pragma unroll
            for (int b = 0; b < 16; ++b) mp[b * 3072 + n] = acc[b];
            LDS_WAIT(); asm volatile("" ::: "memory");
            continue; }
        r -= I_MOD;
        if (r < I_IN) { p0_transpose_item(F.in[6], DM, NPROJ, ws16 + WS_WIN / 2, scr, r, F.lane); continue; } r -= I_IN;
        if (r < I_GLU) { p0_transpose_item(F.in[17], 512, 512, ws16 + WS_WGLU / 2, scr, r, F.lane); continue; } r -= I_GLU;
        if (r < I_UP) { p0_transpose_item(F.in[19], 512, DM, ws16 + WS_WUPA / 2, scr, r, F.lane); continue; } r -= I_UP;
        if (r < I_UP) { p0_transpose_item(F.in[20], 512, DM, ws16 + WS_WUPS / 2, scr, r, F.lane); continue; } r -= I_UP;
        p0_transpose_item(F.in[21], DM, DM, ws16 + WS_WOUT / 2, scr, r, F.lane);
    }
    { const int* pos = (const int*)F.in[2]; float* rope = (float*)(F.ws + WS_ROPE);
      for (int idx = (F.vcu * 512 + F.tid); idx < M * 8; idx += F.G * 512) { const int tok = idx >> 3, i = idx & 7;
          const float invf = __builtin_amdgcn_exp2f(-(float)i * (18.931568569324174f / 8.0f));
          const float ang = (float)pos[tok] * invf;
          rope[tok * 16 + i] = cos_rev(ang); rope[tok * 16 + 8 + i] = sin_rev(ang); } }
}

__device__ __forceinline__ void p1a_norm(Frame& F) {
    LAS float* gs = (LAS float*)(F.lds + RING_OFF); LAS float* sh = gs + 1024;
    const float* modp = (const float*)(F.ws + WS_MODP); const float* b_ada = F.in[4]; const float* g_pre = F.in[5];
    const int rows_per = M / F.G;
    const int r0 = F.vcu * rows_per, b = r0 / SEQ;
    for (int k = F.tid; k < 1024; k += 512) {
        float s_sh = b_ada[k], s_sc = b_ada[1024 + k];
#pragma unroll
        for (int ks = 0; ks < KSL; ++ks) { s_sh += modp[((size_t)ks * 16 + b) * 3072 + k]; s_sc += modp[((size_t)ks * 16 + b) * 3072 + 1024 + k]; }
        gs[k] = g_pre[k] * (1.0f + s_sc); sh[k] = s_sh; }
    { const int sub = (r0 % SEQ) / rows_per;
      if (F.tid < 64 && sub < 16) { const int k = sub * 64 + F.tid; float s = b_ada[2048 + k];
#pragma unroll
          for (int ks = 0; ks < KSL; ++ks) s += modp[((size_t)ks * 16 + b) * 3072 + 2048 + k];
          ((float*)(F.ws + WS_GATE))[b * 1024 + k] = s; } }
    LDS_WAIT(); __syncthreads();
    bf16* H = (bf16*)(F.ws + WS_H);
    for (int r = r0 + F.wave; r < r0 + rows_per; r += NWAVES) {
        const GAS f32x4* xr = (const GAS f32x4*)(F.in[0] + (size_t)r * DM) + F.lane;
        f32x4 v[4]; float s = 0.f;
#pragma unroll
        for (int j = 0; j < 4; ++j) { v[j] = xr[64 * j]; s += (v[j].x * v[j].x + v[j].y * v[j].y) + (v[j].z * v[j].z + v[j].w * v[j].w); }
        const float inv = 1.0f / sqrtf(wave_sum(s) * (1.f / DM) + EPS);
        GAS unsigned long long* o8 = (GAS unsigned long long*)(H + (size_t)r * DM) + F.lane;
#pragma unroll
        for (int j = 0; j < 4; ++j) { const int k = 4 * F.lane + 256 * j; const f32x4 g = *(const LAS f32x4*)(gs + k), s4 = *(const LAS f32x4*)(sh + k);
            const f32x4 h = v[j] * inv * g + s4;
            o8[64 * j] = (unsigned long long)pk2(h.x, h.y) | ((unsigned long long)pk2(h.z, h.w) << 32); }
    }
    __syncthreads();
}

__device__ __forceinline__ void attn_naive_unit(Frame& F, int unit) {
    const int qb = unit & 31, bh = unit >> 5, h = bh & 3, b = bh >> 2;
    const int t = F.tid, row = t & 63, c = (t >> 6) & 1, dq = t >> 7;
    const bf16* QKV = (const bf16*)(F.ws + WS_QKV);
    LAS unsigned char* Kl = F.lds + RING_OFF; LAS unsigned char* Vl = Kl + 8192; LAS float* X = (LAS float*)(F.lds + RING_OFF + 32768); LAS float* SS = X + 64 * 128;
    float q[64];
    { const v4u* qp = (const v4u*)(QKV + (size_t)(b * SEQ + qb * 64 + row) * QKVW + h * 128 + c * 64);
#pragma unroll
      for (int i = 0; i < 8; ++i) { const v4u w = qp[i]; q[8 * i] = bflo(w.x); q[8 * i + 1] = bfhi(w.x); q[8 * i + 2] = bflo(w.y); q[8 * i + 3] = bfhi(w.y);
          q[8 * i + 4] = bflo(w.z); q[8 * i + 5] = bfhi(w.z); q[8 * i + 6] = bflo(w.w); q[8 * i + 7] = bfhi(w.w); } }
    float o[32];
#pragma unroll
    for (int j = 0; j < 32; ++j) o[j] = 0.f;
    float mrun = -1e30f, l = 0.f;
    const int lk = t >> 4, lc = t & 15;
    for (int kt = 0; kt < SEQ / 32; ++kt) {
        __syncthreads();
        { const size_t rowoff = (size_t)(b * SEQ + kt * 32 + lk) * QKVW + h * 128 + lc * 8;
          *(LAS v4u*)(Kl + lk * 256 + lc * 16) = *(const v4u*)(QKV + rowoff + 512);
          *(LAS v4u*)(Vl + lk * 256 + lc * 16) = *(const v4u*)(QKV + rowoff + 1024); }
        LDS_WAIT(); __syncthreads();
#pragma unroll 1
        for (int key = 0; key < 32; ++key) {
            const LAS unsigned char* Kg = Kl + key * 256 + c * 128; const LAS unsigned char* Vg = Vl + key * 256 + dq * 64;
            float a = 0.f;
#pragma unroll
            for (int i = 0; i < 8; ++i) { const v4u w = *(const LAS v4u*)(Kg + i * 16);
                a += q[8 * i] * bflo(w.x) + q[8 * i + 1] * bfhi(w.x) + q[8 * i + 2] * bflo(w.y) + q[8 * i + 3] * bfhi(w.y)
                   + q[8 * i + 4] * bflo(w.z) + q[8 * i + 5] * bfhi(w.z) + q[8 * i + 6] * bflo(w.w) + q[8 * i + 7] * bfhi(w.w); }
            const float mn = fmaxf(mrun, a), alpha = __builtin_amdgcn_exp2f(mrun - mn), p = __builtin_amdgcn_exp2f(a - mn); mrun = mn;
            l = l * alpha + p;
#pragma unroll
            for (int i = 0; i < 4; ++i) { const v4u w = *(const LAS v4u*)(Vg + i * 16);
                o[8 * i] = o[8 * i] * alpha + p * bflo(w.x); o[8 * i + 1] = o[8 * i + 1] * alpha + p * bfhi(w.x); o[8 * i + 2] = o[8 * i + 2] * alpha + p * bflo(w.y); o[8 * i + 3] = o[8 * i + 3] * alpha + p * bfhi(w.y);
                o[8 * i + 4] = o[8 * i + 4] * alpha + p * bflo(w.z); o[8 * i + 5] = o[8 * i + 5] * alpha + p * bfhi(w.z); o[8 * i + 6] = o[8 * i + 6] * alpha + p * bflo(w.w); o[8 * i + 7] = o[8 * i + 7] * alpha + p * bfhi(w.w); }
        }
    }
    const float rl = 1.0f / l;
    float lam; { const float* lq = F.in[7]; float d1 = 0.f, d2 = 0.f; for (int i = 0; i < 64; ++i) { d1 += lq[i] * lq[64 + i]; d2 += lq[128 + i] * lq[192 + i]; } lam = __expf(d1) - __expf(d2) + LAM_INIT; }
    __syncthreads();
    if (c == 1) {
#pragma unroll
        for (int j = 0; j < 32; ++j) X[row * 128 + dq * 32 + j] = o[j] * rl; }
    LDS_WAIT(); __syncthreads();
    float ss = 0.f;
    if (c == 0) {
#pragma unroll
        for (int j = 0; j < 32; ++j) { o[j] = o[j] * rl - lam * X[row * 128 + dq * 32 + j]; ss += o[j] * o[j]; }
        SS[row * 4 + dq] = ss; }
    LDS_WAIT(); __syncthreads();
    if (c == 0) {
        const float inv = 1.0f / sqrtf(((SS[row * 4] + SS[row * 4 + 1]) + (SS[row * 4 + 2] + SS[row * 4 + 3])) * (1.0f / 128.0f) + EPS) * (1.0f - LAM_INIT);
        const float* gsub = F.in[8]; const size_t tok = (size_t)(b * SEQ + qb * 64 + row);
        const v4u* zp = (const v4u*)((const bf16*)(F.ws + WS_ZA) + tok * 512 + h * 128 + dq * 32);
        v4u* op = (v4u*)((bf16*)(F.ws + WS_AIN) + tok * 512 + h * 128 + dq * 32);
#pragma unroll
        for (int i = 0; i < 4; ++i) { const v4u z = zp[i]; float r[8];
#pragma unroll
            for (int e = 0; e < 8; ++e) r[e] = o[8 * i + e] * inv * gsub[dq * 32 + 8 * i + e];
            r[0] *= bflo(z.x); r[1] *= bfhi(z.x); r[2] *= bflo(z.y); r[3] *= bfhi(z.y); r[4] *= bflo(z.z); r[5] *= bfhi(z.z); r[6] *= bflo(z.w); r[7] *= bfhi(z.w);
            v4u w; w.x = pk2(r[0], r[1]); w.y = pk2(r[2], r[3]); w.z = pk2(r[4], r[5]); w.w = pk2(r[6], r[7]); op[i] = w; } }
    __syncthreads();
}

__device__ __forceinline__ float gelu_tanh(float x) { const float u = 0.7978845608028654f * (x + 0.044715f * x * x * x); const float e = __builtin_amdgcn_exp2f(2.0f * LOG2E * u); const float th = 1.0f - 2.0f * __builtin_amdgcn_rcpf(e + 1.0f); return 0.5f * x * (1.0f + th); }
__device__ __forceinline__ void ssm_naive_unit(Frame& F, int unit) {
    const int g = unit & 31, b = unit >> 5, p = F.lane;
    const bf16* U = (const bf16*)(F.ws + WS_U); float* YT = (float*)(F.ws + WS_YTMP); bf16* Y = (bf16*)(F.ws + WS_Y);
    const float* dsk = F.in[16];
    for (int d = 0; d < 2; ++d) {
        const int pg = (d * NG + g);
        const float dt = __expf(F.in[11][pg]);
        const float lr = fminf(F.in[9][pg * NP + p], -1e-4f), li = F.in[10][pg * NP + p];
        const float mag = __expf(lr * dt); const float are = mag * cos_rev(li * dt), aim = mag * sin_rev(li * dt);
        const float den = lr * lr + li * li, nr = are - 1.0f, ni = aim; const float cre_ = (nr * lr + ni * li) / den, cim_ = (ni * lr - nr * li) / den;
        float bre[16], bim[16], cre[16], cim[16];
#pragma unroll
        for (int h = 0; h < 16; ++h) { const float br = F.in[12][((size_t)pg * NP + p) * GH + h], bi = F.in[13][((size_t)pg * NP + p) * GH + h];
            bre[h] = cre_ * br - cim_ * bi; bim[h] = cre_ * bi + cim_ * br;
            cre[h] = F.in[14][((size_t)pg * GH + h) * NP + p]; cim[h] = F.in[15][((size_t)pg * GH + h) * NP + p]; }
        float xr = 0.f, xi = 0.f;
        const int hsel = ((p >> 5) & 1) * 8 + ((p >> 4) & 1) * 4 + ((p >> 3) & 1) * 2 + ((p >> 2) & 1);
        const float dv = dsk[g * GH + hsel];
        for (int st = 0; st < SEQ; ++st) {
            const int t = d ? (SEQ - 1 - st) : st; const size_t tok = (size_t)b * SEQ + t;
            const v4u* up = (const v4u*)(U + tok * SSMW + g * GH); const v4u w0 = up[0], w1 = up[1];
            float u[16]; u[0] = bflo(w0.x); u[1] = bfhi(w0.x); u[2] = bflo(w0.y); u[3] = bfhi(w0.y); u[4] = bflo(w0.z); u[5] = bfhi(w0.z); u[6] = bflo(w0.w); u[7] = bfhi(w0.w);
            u[8] = bflo(w1.x); u[9] = bfhi(w1.x); u[10] = bflo(w1.y); u[11] = bfhi(w1.y); u[12] = bflo(w1.z); u[13] = bfhi(w1.z); u[14] = bflo(w1.w); u[15] = bfhi(w1.w);
            float br = 0.f, bi = 0.f;
#pragma unroll
            for (int h = 0; h < 16; ++h) { br += bre[h] * u[h]; bi += bim[h] * u[h]; }
            const float nxr = are * xr - aim * xi + br, nxi = are * xi + aim * xr + bi; xr = nxr; xi = nxi;
            float v[16];
#pragma unroll
            for (int h = 0; h < 16; ++h) v[h] = cre[h] * xr - cim[h] * xi;
            float w8[8], w4[4], w2[2], w1_;
            { const bool hi = (p & 32) != 0;
#pragma unroll
              for (int k = 0; k < 8; ++k) { const float send = hi ? v[k] : v[k + 8], keep = hi ? v[k + 8] : v[k]; w8[k] = keep + __shfl_xor(send, 32); } }
            { const bool hi = (p & 16) != 0;
#pragma unroll
              for (int k = 0; k < 4; ++k) { const float send = hi ? w8[k] : w8[k + 4], keep = hi ? w8[k + 4] : w8[k]; w4[k] = keep + __shfl_xor(send, 16); } }
            { const bool hi = (p & 8) != 0;
#pragma unroll
              for (int k = 0; k < 2; ++k) { const float send = hi ? w4[k] : w4[k + 2], keep = hi ? w4[k + 2] : w4[k]; w2[k] = keep + __shfl_xor(send, 8); } }
            { const bool hi = (p & 4) != 0; const float send = hi ? w2[0] : w2[1], keep = hi ? w2[1] : w2[0]; w1_ = keep + __shfl_xor(send, 4); }
            w1_ += __shfl_xor(w1_, 2); w1_ += __shfl_xor(w1_, 1);
            if ((p & 3) == 0) {
                if (d == 0) YT[tok * SSMW + g * GH + hsel] = w1_;
                else { const float uh = __uint_as_float((unsigned)U[tok * SSMW + g * GH + hsel] << 16);
                       const float y = YT[tok * SSMW + g * GH + hsel] + w1_ + dv * uh; Y[tok * SSMW + g * GH + hsel] = (bf16)f2bf(gelu_tanh(y)); } }
        }
        asm volatile("s_waitcnt vmcnt(0)" ::: "memory");
    }
}

__device__ __forceinline__ void p6_final_norm(Frame& F) {
    const int gw = F.vcu * NWAVES + F.wave, NGW = F.G * NWAVES;
    const float* rowss = (const float*)(F.ctl + CW_ROWSS); const float* gf = F.in[22];
    f32x4 g4[4];
#pragma unroll
    for (int j = 0; j < 4; ++j) g4[j] = *(const f32x4*)(gf + 4 * F.lane + 256 * j);
    for (int r = gw; r < M; r += NGW) { const float inv = 1.0f / sqrtf(rowss[r] * (1.f / DM) + EPS);
        GAS f32x4* o = (GAS f32x4*)(F.out + (size_t)r * DM) + F.lane;
#pragma unroll
        for (int j = 0; j < 4; ++j) o[64 * j] = o[64 * j] * inv * g4[j]; }
}
#ifndef MK_N_LAUNCHES
#define MK_N_LAUNCHES 9
#endif
constexpr int N_PHASES = 9;
struct Args { const float* in[23]; float* out; unsigned char* ws; int ph_lo, ph_hi; };
__global__ void __launch_bounds__(NWAVES * 64, 2) fwd_kernel(Args args) {
    extern __shared__ __attribute__((aligned(16))) unsigned char lds[];
    Frame F;
    F.lds = (LAS unsigned char*)lds;
    F.MISC = (volatile LAS unsigned*)(F.lds + MISC_OFF);
    F.tid = threadIdx.x; F.lane = F.tid & 63; F.wave = __builtin_amdgcn_readfirstlane(F.tid >> 6);
    F.G = gridDim.x; { const int bx = blockIdx.x; F.vcu = (F.G % 8 == 0) ? (bx % 8) * (F.G / 8) + bx / 8 : bx; }
    F.ws = args.ws; F.out = args.out; F.ctl = (gu32*)(args.ws + WS_CTL);
#pragma unroll
    for (int i = 0; i < 23; ++i) F.in[i] = args.in[i];
    for (int u = F.tid; u < (LDS_BYTES - LDSCTL_OFF) / 4; u += NWAVES * 64) ((LAS unsigned*)(F.lds + LDSCTL_OFF))[u] = 0u;
    __syncthreads();
    const int lo = args.ph_lo, hi = args.ph_hi;
    const bool multi = (hi - lo) > 1;
    XcdBarrier bar; bar.bar = (unsigned*)(F.ctl + CW_BAR); bar.x = 0; bar.st = nullptr;
    if (multi) bar = xcd_barrier_post((unsigned*)(F.ctl + CW_BAR), F.MISC + 8);
#define IN(k) (lo <= (k) && (k) < hi)
#define SEAM(k) do { if (IN(k) && IN((k) + 1)) xcd_barrier(bar); } while (0)
    bf16* ws16 = (bf16*)args.ws;
    if (IN(0)) { p0_prologue(F); SEAM(0); }
    if (IN(1)) { p1a_norm(F); SEAM(1); }
    if (IN(2)) {
        pg8::Gemm g{ws16 + WS_H / 2, ws16 + WS_WIN / 2, M, NPROJ, DM}; pg8::StaticOrder S; S.init(M, NPROJ, F.G, (int)blockIdx.x);
        pg8::EpiProj E{ws16 + WS_QKV / 2, ws16 + WS_ZA / 2, ws16 + WS_U / 2, ws16 + WS_ZS / 2, ws16 + WS_GA / 2, ws16 + WS_GS / 2, (const float*)(args.ws + WS_ROPE), QSCALE};
        pg8::gemm_phase<pg8::EpiProj, pg8::StaticOrder, true, true>(F.lds + RING_OFF, g, S, E);
        SEAM(2); }
    if (IN(3)) {
        for (int u = F.vcu; u < NB * NH * 32; u += F.G) attn_naive_unit(F, u);
        { const int gw = F.vcu * NWAVES + F.wave; if ((gw & 3) == 0 && (gw >> 2) < NB * NG) ssm_naive_unit(F, gw >> 2); }
        SEAM(3); }
    if (IN(4)) {
        pg8::Gemm g{ws16 + WS_Y / 2, ws16 + WS_WGLU / 2, M, 512, 512}; pg8::StaticOrder S; S.init(M, 512, F.G, (int)blockIdx.x);
        pg8::EpiGlu E{ws16 + WS_Y / 2, ws16 + WS_ZS / 2, ws16 + WS_Y2 / 2, F.in[18]};
        pg8::gemm_phase<pg8::EpiGlu, pg8::StaticOrder, true, true>(F.lds + RING_OFF, g, S, E);
        SEAM(4); }
    if (IN(5)) {
        pg8::Gemm g{ws16 + WS_AIN / 2, ws16 + WS_WUPA / 2, M, DM, 512}; pg8::StaticOrder S; S.init(M, DM, F.G, (int)blockIdx.x);
        pg8::EpiMerge<0> E{ws16 + WS_GA / 2, nullptr};
        pg8::gemm_phase<pg8::EpiMerge<0>, pg8::StaticOrder, true, true>(F.lds + RING_OFF, g, S, E);
        SEAM(5); }
    if (IN(6)) {
        pg8::Gemm g{ws16 + WS_Y2 / 2, ws16 + WS_WUPS / 2, M, DM, 512}; pg8::StaticOrder S; S.init(M, DM, F.G, (int)blockIdx.x);
        pg8::EpiMerge<1> E{ws16 + WS_GA / 2, ws16 + WS_GS / 2};
        pg8::gemm_phase<pg8::EpiMerge<1>, pg8::StaticOrder, true, true>(F.lds + RING_OFF, g, S, E);
        SEAM(6); }
    if (IN(7)) {
        pg8::Gemm g{ws16 + WS_GA / 2, ws16 + WS_WOUT / 2, M, DM, DM}; pg8::StaticOrder S; S.init(M, DM, F.G, (int)blockIdx.x);
        pg8::EpiOut E{F.in[0], (const float*)(args.ws + WS_GATE), F.out, (float*)(F.ctl + CW_ROWSS)};
        pg8::gemm_phase<pg8::EpiOut, pg8::StaticOrder, true, true>(F.lds + RING_OFF, g, S, E);
        SEAM(7); }
    if (IN(8)) { p6_final_norm(F); }
#undef IN
#undef SEAM
}

extern "C" void kernel_launch(void* const* d_in, const int* in_sizes, int n_in, void* d_out, int out_size, void* d_ws, size_t ws_size, hipStream_t stream) {
    static int grid = 0;
    if (grid == 0) {
        if (n_in != 23 || in_sizes[0] != M * DM || out_size != M * DM || ws_size < WS_END) { fprintf(stderr, "kernel_launch: shape/workspace mismatch (n_in %d, in0 %d, out %d, ws %zu)\n", n_in, n_in > 0 ? in_sizes[0] : -1, out_size, ws_size); grid = -1; return; }
        if (hipFuncSetAttribute((const void*)fwd_kernel, hipFuncAttributeMaxDynamicSharedMemorySize, LDS_BYTES) != hipSuccess) { fprintf(stderr, "kernel_launch: hipFuncSetAttribute failed\n"); grid = -1; return; }
        int per_cu = 0;
        if (hipOccupancyMaxActiveBlocksPerMultiprocessor(&per_cu, (const void*)fwd_kernel, NWAVES * 64, LDS_BYTES) != hipSuccess || per_cu < 1) fprintf(stderr, "kernel_launch: occupancy query reports %d\n", per_cu);
        (void)hipGetLastError();
        grid = 256;
    }
    if (grid < 0) return;
    if (hipMemsetAsync((char*)d_ws + WS_CTL, 0, CTL_ZERO_BYTES, stream) != hipSuccess) { fprintf(stderr, "kernel_launch: memset failed\n"); return; }
    Args a{};
    for (int i = 0; i < 23; ++i) a.in[i] = (const float*)d_in[i];
    a.out = (float*)d_out; a.ws = (unsigned char*)d_ws;
    if (MK_N_LAUNCHES == 1) { a.ph_lo = 0; a.ph_hi = N_PHASES; hipLaunchKernelGGL(fwd_kernel, dim3(grid), dim3(NWAVES * 64), LDS_BYTES, stream, a); }
    else for (int p = 0; p < N_PHASES; ++p) { a.ph_lo = p; a.ph_hi = p + 1; hipLaunchKernelGGL(fwd_kernel, dim3(grid), dim3(NWAVES * 64), LDS_BYTES, stream, a); }
    const hipError_t le = hipPeekAtLastError();
    if (le != hipSuccess) fprintf(stderr, "kernel_launch: launch failed: %s\n", hipGetErrorName(le));
}
```

```cpp
#include <hip/hip_runtime.h>
#include <cstdio>
#include <cstdint>
namespace pg8 {
#define PG8_LAS __attribute__((address_space(3)))
typedef unsigned short bf16_t;
typedef short bf16x8 __attribute__((ext_vector_type(8)));
typedef float f32x4 __attribute__((ext_vector_type(4)));
typedef unsigned u32x4 __attribute__((ext_vector_type(4)));
constexpr int BM = 256, BK = 64, HALF = 128, HTB = HALF * BK * 2  , STAGE_BYTES = 8 * HTB, NXCD = 8, WGM = 8;

__host__ __device__ __forceinline__ int lds_byte(int r, int c) { const int st = (r >> 4) * 2 + (c >> 5), rr = r & 15, cc = c & 31, ob = rr * 64 + cc * 2; return st * 1024 + (ob ^ (((ob >> 9) & 1) << 5)); }
__host__ __device__ __forceinline__ void stage_rc(int b, int& R, int& C) { const int st = b / 1024, sb = b % 1024, swz = sb ^ (((sb >> 9) & 1) << 5); R = (st >> 1) * 16 + swz / 64; C = (st & 1) * 32 + (swz % 64) / 2; }
__host__ __device__ __forceinline__ int perm32(int rho) { const int n = rho >> 4, i = rho & 15; return 8 * (i >> 2) + 4 * n + (i & 3); }

struct Unit { int pm, pn; };
struct Gemm { const bf16_t* A; const bf16_t* Bt; int M, N, K; };

struct StaticOrder {
    int nM, nN, nwg, G, c;
    __host__ __device__ void init(int M, int N, int G_, int c_) { nM = M / BM; nN = N / BM; nwg = nM * nN; G = G_; c = c_; }
    __host__ __device__ bool next(int i, Unit& u) const {
        const long L = (long)i * G + c; if (L >= nwg) return false;
        int wgid = (int)L; { const int q = nwg / NXCD, r = nwg % NXCD, xcd = wgid % NXCD, off = wgid / NXCD; wgid = (xcd < r ? xcd * (q + 1) : r * (q + 1) + (xcd - r) * q) + off; }
        const int nig = WGM * nN, gid = wgid / nig, fm = gid * WGM, gsz = (nM - fm) < WGM ? (nM - fm) : WGM;
        u.pm = fm + ((wgid % nig) % gsz); u.pn = (wgid % nig) / gsz; return true;
    }
    __device__ __forceinline__ void a_ready(const Unit&) const {}
    __device__ __forceinline__ void done(const Unit&) const {}
};

__device__ __forceinline__ unsigned cvt_pk_bf16(float lo, float hi) { unsigned r; asm volatile("v_cvt_pk_bf16_f32 %0, %1, %2" : "=v"(r) : "v"(lo), "v"(hi)); return r; }
__device__ __forceinline__ float bf_lo(unsigned w) { return __uint_as_float(w << 16); }
__device__ __forceinline__ float bf_hi(unsigned w) { return __uint_as_float(w & 0xffff0000u); }
__device__ __forceinline__ float sigmoid_f(float x) { return __builtin_amdgcn_rcpf(1.0f + __builtin_amdgcn_exp2f(-1.4426950408889634f * x)); }
__device__ __forceinline__ void unpack8(const u32x4 w, float (&f)[8]) { f[0] = bf_lo(w.x); f[1] = bf_hi(w.x); f[2] = bf_lo(w.y); f[3] = bf_hi(w.y); f[4] = bf_lo(w.z); f[5] = bf_hi(w.z); f[6] = bf_lo(w.w); f[7] = bf_hi(w.w); }
__device__ __forceinline__ u32x4 pack8(const float (&f)[8]) { u32x4 w; w.x = cvt_pk_bf16(f[0], f[1]); w.y = cvt_pk_bf16(f[2], f[3]); w.z = cvt_pk_bf16(f[4], f[5]); w.w = cvt_pk_bf16(f[6], f[7]); return w; }

struct EpiProj {
    static constexpr bool PERM = true, AFTER_DRAIN = false;
    bf16_t *QKV, *ZA, *U, *ZS, *GA, *GS; const float* rope; float qscale;
    __device__ __forceinline__ void operator()(const f32x4 (&acc)[2][2][4][2], const Unit& u, int wr, int wc, int fr, int fq) const {
        const int pn = u.pn; bf16_t* base; int ldc, colt, act;
        float sc = 1.f;
        if (pn < 2)       { base = QKV; ldc = 1536; colt = pn * 256; act = 3; sc = qscale; }
        else if (pn < 4)  { base = QKV; ldc = 1536; colt = 512 + (pn - 2) * 256; act = 3; }
        else if (pn < 6)  { base = QKV; ldc = 1536; colt = 1024 + (pn - 4) * 256; act = 0; }
        else if (pn < 8)  { base = ZA; ldc = 512; colt = (pn - 6) * 256; act = 1; }
        else if (pn < 10) { base = U;  ldc = 512; colt = (pn - 8) * 256; act = 0; }
        else if (pn < 12) { base = ZS; ldc = 512; colt = (pn - 10) * 256; act = 1; }
        else if (pn < 16) { base = GA; ldc = 1024; colt = (pn - 12) * 256; act = 2; }
        else              { base = GS; ldc = 1024; colt = (pn - 16) * 256; act = 2; }
        const int row0 = u.pm * BM + wr * 64 + fr, col0 = colt + wc * 32 + 8 * fq;
        const bool rotw = (act == 3) && ((wc & 1) == 0);
#pragma unroll
        for (int ai = 0; ai < 2; ++ai)
#pragma unroll
            for (int m = 0; m < 4; ++m) {
                const int row = row0 + ai * HALF + m * 16; bf16_t* rowp = base + (size_t)row * ldc + col0;
                float cs[8], sn[8];
                if (rotw) { const f32x4* rp = (const f32x4*)(rope + (size_t)row * 16); const f32x4 c0 = rp[0], c1 = rp[1], s0 = rp[2], s1 = rp[3];
                    cs[0] = c0[0]; cs[1] = c0[1]; cs[2] = c0[2]; cs[3] = c0[3]; cs[4] = c1[0]; cs[5] = c1[1]; cs[6] = c1[2]; cs[7] = c1[3];
                    sn[0] = s0[0]; sn[1] = s0[1]; sn[2] = s0[2]; sn[3] = s0[3]; sn[4] = s1[0]; sn[5] = s1[1]; sn[6] = s1[2]; sn[7] = s1[3]; }
#pragma unroll
                for (int bj = 0; bj < 2; ++bj) {
                    float v[8];
#pragma unroll
                    for (int e = 0; e < 4; ++e) { v[e] = acc[ai][bj][m][0][e]; v[4 + e] = acc[ai][bj][m][1][e]; }
                    if (act == 1) {
#pragma unroll
                        for (int e = 0; e < 8; ++e) v[e] = v[e] * sigmoid_f(v[e]);
                    } else if (act == 2) {
#pragma unroll
                        for (int e = 0; e < 8; ++e) v[e] = sigmoid_f(v[e]);
                    } else if (act == 3) {
                        if (rotw) {
#pragma unroll
                            for (int e = 0; e < 8; ++e) { const float o = __shfl_xor(v[e], 16);
                                const float r1 = v[e] * cs[e] - o * sn[e], r2 = v[e] * cs[e] + o * sn[e];
                                v[e] = (fq == 0) ? r1 : ((fq == 1) ? r2 : v[e]); }
                        }
#pragma unroll
                        for (int e = 0; e < 8; ++e) v[e] *= sc;
                    }
                    *(u32x4*)(rowp + bj * HALF) = pack8(v);
                }
            }
    }
};
struct EpiGlu {
    static constexpr bool PERM = true, AFTER_DRAIN = false;
    const bf16_t *Y, *ZS; bf16_t* Y2; const float* bias;
    __device__ __forceinline__ void operator()(const f32x4 (&acc)[2][2][4][2], const Unit& u, int wr, int wc, int fr, int fq) const {
        const int row0 = u.pm * BM + wr * 64 + fr, col0 = u.pn * BM + wc * 32 + 8 * fq;
#pragma unroll
        for (int ai = 0; ai < 2; ++ai)
#pragma unroll
            for (int m = 0; m < 4; ++m) { const size_t off = (size_t)(row0 + ai * HALF + m * 16) * 512 + col0;
#pragma unroll
                for (int bj = 0; bj < 2; ++bj) {
                    const f32x4 b0 = *(const f32x4*)(bias + col0 + bj * HALF), b1 = *(const f32x4*)(bias + col0 + bj * HALF + 4);
                    float yv[8], zv[8], v[8]; unpack8(*(const u32x4*)(Y + off + bj * HALF), yv); unpack8(*(const u32x4*)(ZS + off + bj * HALF), zv);
#pragma unroll
                    for (int e = 0; e < 4; ++e) { v[e] = yv[e] * sigmoid_f(acc[ai][bj][m][0][e] + b0[e]) * zv[e]; v[4 + e] = yv[4 + e] * sigmoid_f(acc[ai][bj][m][1][e] + b1[e]) * zv[4 + e]; }
                    *(u32x4*)(Y2 + off + bj * HALF) = pack8(v);
                } }
    }
};
template <int MODE> struct EpiMerge {
    static constexpr bool PERM = true, AFTER_DRAIN = false;
    bf16_t* G; const bf16_t* G2;
    __device__ __forceinline__ void operator()(const f32x4 (&acc)[2][2][4][2], const Unit& u, int wr, int wc, int fr, int fq) const {
        const int row0 = u.pm * BM + wr * 64 + fr, col0 = u.pn * BM + wc * 32 + 8 * fq;
#pragma unroll
        for (int ai = 0; ai < 2; ++ai)
#pragma unroll
            for (int m = 0; m < 4; ++m) { const size_t off = (size_t)(row0 + ai * HALF + m * 16) * 1024 + col0;
#pragma unroll
                for (int bj = 0; bj < 2; ++bj) {
                    float g[8], v[8]; unpack8(*(const u32x4*)(G + off + bj * HALF), g);
                    if (MODE == 0) {
#pragma unroll
                        for (int e = 0; e < 4; ++e) { v[e] = g[e] * acc[ai][bj][m][0][e]; v[4 + e] = g[4 + e] * acc[ai][bj][m][1][e]; }
                    } else { float g2[8]; unpack8(*(const u32x4*)(G2 + off + bj * HALF), g2);
#pragma unroll
                        for (int e = 0; e < 4; ++e) { v[e] = g[e] + g2[e] * acc[ai][bj][m][0][e]; v[4 + e] = g[4 + e] + g2[4 + e] * acc[ai][bj][m][1][e]; }
                    }
                    *(u32x4*)(G + off + bj * HALF) = pack8(v);
                } }
    }
};
struct EpiOut {
    static constexpr bool PERM = true, AFTER_DRAIN = false;
    const float* x; const float* gate; float* out; float* rowss;
    __device__ __forceinline__ void operator()(const f32x4 (&acc)[2][2][4][2], const Unit& u, int wr, int wc, int fr, int fq) const {
        const int row0 = u.pm * BM + wr * 64 + fr, col0 = u.pn * BM + wc * 32 + 8 * fq;
        const float* gb = gate + (size_t)((u.pm * BM) >> 11) * 1024;
        f32x4 g[2][2];
#pragma unroll
        for (int bj = 0; bj < 2; ++bj) { g[bj][0] = *(const f32x4*)(gb + col0 + bj * HALF); g[bj][1] = *(const f32x4*)(gb + col0 + bj * HALF + 4); }
#pragma unroll
        for (int ai = 0; ai < 2; ++ai)
#pragma unroll
            for (int m = 0; m < 4; ++m) { const int row = row0 + ai * HALF + m * 16; const size_t off = (size_t)row * 1024 + col0; float ss = 0.f;
#pragma unroll
                for (int bj = 0; bj < 2; ++bj)
#pragma unroll
                    for (int n = 0; n < 2; ++n) { const f32x4 xv = *(const f32x4*)(x + off + bj * HALF + 4 * n); const f32x4 o = xv + g[bj][n] * acc[ai][bj][m][n];
                        *(f32x4*)(out + off + bj * HALF + 4 * n) = o; ss += (o[0] * o[0] + o[1] * o[1]) + (o[2] * o[2] + o[3] * o[3]); }
                ss += __shfl_xor(ss, 16); ss += __shfl_xor(ss, 32);
                if (fq == 0) atomicAdd(rowss + row, ss); }
    }
};

template <class Epi, class Sched, bool ALIGN_EPI = false, bool SP2 = false>
__device__ __forceinline__ void gemm_phase(PG8_LAS unsigned char* lds, const Gemm g, const Sched& S, const Epi& E) {
    const int tid = threadIdx.x, wid = __builtin_amdgcn_readfirstlane(tid >> 6), lane = tid & 63, wr = wid >> 2, wc = wid & 3, fr = lane & 15, fq = lane >> 4;
    const int K = g.K, nt = K / BK;
    unsigned voffA[2], voffB[2];
#pragma unroll
    for (int i = 0; i < 2; ++i) { int R, C; stage_rc(tid * 16 + i * 8192, R, C); const int Rb = Epi::PERM ? ((R & ~31) + perm32(R & 31)) : R;
        voffA[i] = (unsigned)(R * K + C) * 2u; voffB[i] = (unsigned)(Rb * K + C) * 2u; }
    const size_t kstep = (size_t)(BK * 2);
    const size_t hstep = (size_t)HALF * K * 2;
    const size_t tstep = 2 * hstep;
    const unsigned ldsw = (unsigned)wid * 1024u;
    const int aoff = lds_byte(wr * 64 + fr, fq * 8), boff = lds_byte(wc * 32 + fr, fq * 8);
#define PG8_SA(b, h) (((b) * 2 + (h)) * HTB)
#define PG8_SB(b, h) ((4 + (b) * 2 + (h)) * HTB)
#define PG8_STAGE(bufoff, gbase, voff) do { _Pragma("unroll") for (int _i = 0; _i < 2; ++_i) \
        __builtin_amdgcn_global_load_lds((const unsigned*)((const char*)(gbase) + (voff)[_i]), (PG8_LAS unsigned*)(lds + (bufoff) + ldsw + _i * 8192), 16, 0, 0); } while (0)
#define PG8_LDA(dst, b, h) do { _Pragma("unroll") for (int m = 0; m < 4; ++m) _Pragma("unroll") for (int k = 0; k < 2; ++k) dst[m][k] = *(const PG8_LAS bf16x8*)(lds + PG8_SA(b, h) + aoff + m * 2048 + k * 1024); } while (0)
#define PG8_LDB(dst, b, h) do { _Pragma("unroll") for (int n = 0; n < 2; ++n) _Pragma("unroll") for (int k = 0; k < 2; ++k) dst[n][k] = *(const PG8_LAS bf16x8*)(lds + PG8_SB(b, h) + boff + n * 2048 + k * 1024); } while (0)
#define PG8_MMA(ai, bj, At, Bt) do { __builtin_amdgcn_s_setprio(1); _Pragma("unroll") for (int m = 0; m < 4; ++m) _Pragma("unroll") for (int n = 0; n < 2; ++n) _Pragma("unroll") for (int k = 0; k < 2; ++k) \
        acc[ai][bj][m][n] = __builtin_amdgcn_mfma_f32_16x16x32_bf16(Bt[n][k], At[m][k], acc[ai][bj][m][n], 0, 0, 0); __builtin_amdgcn_s_setprio(0); } while (0)
#define PG8_WAIT_V(n) asm volatile("s_waitcnt vmcnt(" #n ")" ::: "memory")
#define PG8_WAIT_L(n) asm volatile("s_waitcnt lgkmcnt(" #n ")" ::: "memory")
#define PG8_BAR __builtin_amdgcn_s_barrier()
#define PG8_SCHED __builtin_amdgcn_sched_barrier(0)
    Unit cur, nxt; int ui = 0;
    if (!S.next(0, cur)) return;
    f32x4 acc[2][2][4][2];
#pragma unroll
    for (int a = 0; a < 2; ++a)
#pragma unroll
        for (int b = 0; b < 2; ++b)
#pragma unroll
            for (int m = 0; m < 4; ++m)
#pragma unroll
                for (int n = 0; n < 2; ++n) acc[a][b][m][n] = (f32x4){0.f, 0.f, 0.f, 0.f};
    bf16x8 At[4][2], B0[2][2], B1[2][2];
    const char* cA = (const char*)g.A + (size_t)cur.pm * tstep; const char* cB = (const char*)g.Bt + (size_t)cur.pn * tstep;
    S.a_ready(cur);
    if constexpr (SP2) {
        PG8_STAGE(PG8_SB(0, 0), cB, voffB); PG8_STAGE(PG8_SB(0, 1), cB + hstep, voffB); PG8_STAGE(PG8_SA(0, 0), cA, voffA); PG8_STAGE(PG8_SA(0, 1), cA + hstep, voffA);
        if (wr == 1) PG8_BAR;
        PG8_WAIT_V(2); PG8_BAR;
        PG8_STAGE(PG8_SB(1, 0), cB + kstep, voffB); PG8_STAGE(PG8_SA(1, 0), cA + kstep, voffA); PG8_STAGE(PG8_SB(1, 1), cB + hstep + kstep, voffB);
        PG8_WAIT_V(6); PG8_BAR;
    } else {
        PG8_STAGE(PG8_SB(0, 0), cB, voffB); PG8_STAGE(PG8_SA(0, 0), cA, voffA); PG8_STAGE(PG8_SB(0, 1), cB + hstep, voffB); PG8_STAGE(PG8_SA(0, 1), cA + hstep, voffA);
        if (wr == 1) PG8_BAR;
        PG8_WAIT_V(4); PG8_BAR;
        PG8_STAGE(PG8_SB(1, 0), cB + kstep, voffB); PG8_STAGE(PG8_SA(1, 0), cA + kstep, voffA); PG8_STAGE(PG8_SB(1, 1), cB + hstep + kstep, voffB);
        PG8_WAIT_V(6); PG8_BAR;
    }
    for (;;) {
        const bool has_next = S.next(ui + 1, nxt);
        const char* nA = has_next ? (const char*)g.A + (size_t)nxt.pm * tstep : cA; const char* nB = has_next ? (const char*)g.Bt + (size_t)nxt.pn * tstep : cB;
        for (int t = 0; t < nt; t += 2) {
            const bool last = (t == nt - 2);
            const char* a1 = cA + (size_t)(t + 1) * kstep;
            const char* a2 = last ? nA : cA + (size_t)(t + 2) * kstep; const char* b2 = last ? nB : cB + (size_t)(t + 2) * kstep;
            const char* a3 = a2 + kstep; const char* b3 = b2 + kstep;
            if (last && has_next) S.a_ready(nxt);
            if constexpr (SP2) {
            PG8_LDB(B0, 0, 0); PG8_LDB(B1, 0, 1); PG8_SCHED; PG8_LDA(At, 0, 0); PG8_STAGE(PG8_SA(1, 1), a1 + hstep, voffA);
            PG8_WAIT_V(8); PG8_WAIT_L(0); PG8_BAR; PG8_MMA(0, 0, At, B0); PG8_MMA(0, 1, At, B1); PG8_BAR; PG8_SCHED;
            PG8_LDA(At, 0, 1); PG8_STAGE(PG8_SB(0, 0), b2, voffB); PG8_STAGE(PG8_SB(0, 1), b2 + hstep, voffB); PG8_STAGE(PG8_SA(0, 0), a2, voffA);
            PG8_WAIT_V(8); PG8_WAIT_L(0); PG8_BAR; PG8_MMA(1, 0, At, B0); PG8_MMA(1, 1, At, B1); PG8_BAR; PG8_SCHED;
            PG8_LDB(B0, 1, 0); PG8_LDB(B1, 1, 1); PG8_SCHED; PG8_LDA(At, 1, 0); PG8_STAGE(PG8_SA(0, 1), a2 + hstep, voffA);
            PG8_WAIT_V(8); PG8_WAIT_L(0); PG8_BAR; PG8_MMA(0, 0, At, B0); PG8_MMA(0, 1, At, B1); PG8_BAR; PG8_SCHED;
            PG8_LDA(At, 1, 1); PG8_STAGE(PG8_SB(1, 0), b3, voffB); PG8_STAGE(PG8_SB(1, 1), b3 + hstep, voffB); PG8_STAGE(PG8_SA(1, 0), a3, voffA);
            PG8_WAIT_V(8); PG8_WAIT_L(0); PG8_BAR; PG8_MMA(1, 0, At, B0); PG8_MMA(1, 1, At, B1); PG8_BAR; PG8_SCHED;
            } else {
            PG8_LDB(B0, 0, 0); PG8_SCHED; PG8_LDA(At, 0, 0); PG8_STAGE(PG8_SA(1, 1), a1 + hstep, voffA);
            PG8_WAIT_L(8); PG8_BAR; PG8_WAIT_L(0); PG8_MMA(0, 0, At, B0); PG8_BAR; PG8_SCHED;
            PG8_LDB(B1, 0, 1); PG8_STAGE(PG8_SB(0, 0), b2, voffB);
            PG8_BAR; PG8_WAIT_L(0); PG8_MMA(0, 1, At, B1); PG8_BAR;
            PG8_LDA(At, 0, 1); PG8_STAGE(PG8_SA(0, 0), a2, voffA);
            PG8_BAR; PG8_WAIT_L(0); PG8_MMA(1, 0, At, B0); PG8_BAR; PG8_SCHED;
            PG8_STAGE(PG8_SB(0, 1), b2 + hstep, voffB);
            PG8_WAIT_V(6); PG8_BAR; PG8_MMA(1, 1, At, B1); PG8_BAR;
            PG8_LDB(B0, 1, 0); PG8_SCHED; PG8_LDA(At, 1, 0); PG8_STAGE(PG8_SA(0, 1), a2 + hstep, voffA);
            PG8_WAIT_L(8); PG8_BAR; PG8_WAIT_L(0); PG8_MMA(0, 0, At, B0); PG8_BAR; PG8_SCHED;
            PG8_LDB(B1, 1, 1); PG8_STAGE(PG8_SB(1, 0), b3, voffB);
            PG8_BAR; PG8_WAIT_L(0); PG8_MMA(0, 1, At, B1); PG8_BAR;
            PG8_LDA(At, 1, 1); PG8_STAGE(PG8_SA(1, 0), a3, voffA);
            PG8_BAR; PG8_WAIT_L(0); PG8_MMA(1, 0, At, B0); PG8_BAR; PG8_SCHED;
            PG8_STAGE(PG8_SB(1, 1), b3 + hstep, voffB);
            PG8_WAIT_V(6); PG8_BAR; PG8_MMA(1, 1, At, B1); PG8_BAR;
            }
        }
        if constexpr (ALIGN_EPI) { if (wr == 0) PG8_BAR; }
        if constexpr (!Epi::AFTER_DRAIN) { E(acc, cur, wr, wc, fr, fq); S.done(cur); }
        if (!has_next) break;
#pragma unroll
        for (int a = 0; a < 2; ++a)
#pragma unroll
            for (int b = 0; b < 2; ++b)
#pragma unroll
                for (int m = 0; m < 4; ++m)
#pragma unroll
                    for (int n = 0; n < 2; ++n) acc[a][b][m][n] = (f32x4){0.f, 0.f, 0.f, 0.f};
        cur = nxt; cA = nA; cB = nB; ++ui;
        if constexpr (ALIGN_EPI) { if (wr == 1) PG8_BAR; }
    }
    PG8_WAIT_V(0);
    if constexpr (!ALIGN_EPI) { if (wr == 0) PG8_BAR; }
    PG8_BAR;
    if constexpr (Epi::AFTER_DRAIN) { E.fused(acc, cur, wr, wc, fr, fq, lds, wid, lane); S.done(cur); }
#undef PG8_SA
#undef PG8_SB
#undef PG8_STAGE
#undef PG8_LDA
#undef PG8_LDB
#undef PG8_MMA
#undef PG8_WAIT_V
#undef PG8_WAIT_L
#undef PG8_BAR
#undef PG8_SCHED
}
}
#define GAS __attribute__((address_space(1)))
#define LAS __attribute__((address_space(3)))
typedef unsigned short bf16;
typedef unsigned v4u __attribute__((ext_vector_type(4)));
typedef float f32x4 __attribute__((ext_vector_type(4)));
typedef short bf16x8 __attribute__((ext_vector_type(8)));
typedef GAS unsigned gu32;
typedef GAS unsigned long long gu64;
#define RLX_AGENT __ATOMIC_RELAXED, __HIP_MEMORY_SCOPE_AGENT
#define LDS_WAIT() asm volatile("s_waitcnt lgkmcnt(0)" ::: "memory")
#define VM_WAIT() asm volatile("s_waitcnt vmcnt(0)" ::: "memory")
__device__ __forceinline__ unsigned long long rt() { return __builtin_amdgcn_s_memrealtime(); }
__device__ __forceinline__ unsigned f2bf(float f) { unsigned u = __builtin_bit_cast(unsigned, f); return (u + 0x7fffu + ((u >> 16) & 1u)) >> 16; }
__device__ __forceinline__ unsigned pk2(float lo, float hi) { return f2bf(lo) | (f2bf(hi) << 16); }

#define XB_TMO      128
#define XB_XCNT(j)  (256  + 64 * (j))
#define XB_XSUB(j)  (1280 + 64 * (j))
#define XB_XGEN(j)  (2304 + 64 * (j))
#define XB_TOP      3328
#define XB_TOPGEN   3392
#define XCD_BAR_WORDS 3456
#define XB_SPIN_CAP (1u << 18)

__device__ __forceinline__ unsigned xb_ld(unsigned* p)              { return __hip_atomic_load(p, __ATOMIC_RELAXED, __HIP_MEMORY_SCOPE_AGENT); }
__device__ __forceinline__ unsigned xb_add(unsigned* p, unsigned v) { return __hip_atomic_fetch_add(p, v, __ATOMIC_RELAXED, __HIP_MEMORY_SCOPE_AGENT); }
__device__ __forceinline__ unsigned xb_xcc_id() { return (unsigned)__builtin_amdgcn_s_getreg((3 << 11) | 20) & 0xFu; }
#define XB_SPIN(cond, bar) do { unsigned _sp = 0; while (cond) { __builtin_amdgcn_s_sleep(1); \
    if ((++_sp & 255u) == 0u) { if (xb_ld(&(bar)[XB_TMO])) break; if (_sp > XB_SPIN_CAP) { atomicAdd(&(bar)[XB_TMO], 1u); break; } } } } while (0)

struct XcdBarrier {
    unsigned* bar; unsigned x;
    volatile LAS unsigned* st;
};

__device__ __forceinline__ XcdBarrier xcd_barrier_post(unsigned* bar, volatile LAS unsigned* st) {
    XcdBarrier b; b.bar = bar; b.x = xb_xcc_id(); b.st = st;
    if (threadIdx.x == 0) (void)xb_add(&bar[XB_XCNT(b.x)], 1u);
    return b;
}
__device__ __forceinline__ void xcd_barrier_complete(unsigned* bar, unsigned x, unsigned& nloc, unsigned& nx) {
    const unsigned G = gridDim.x * gridDim.y * gridDim.z;
    unsigned sum, cnt, mine, sp = 0u;
    for (;;) {
        sum = 0u; cnt = 0u; mine = 0u;
#pragma unroll
        for (unsigned j = 0; j < 16; ++j) { const unsigned c = xb_ld(&bar[XB_XCNT(j)]); sum += c; cnt += (c > 0u) ? 1u : 0u; mine = (j == x) ? c : mine; }
        if (sum == G) break;
        __builtin_amdgcn_s_sleep(1);
        if ((++sp & 255u) == 0u) { if (xb_ld(&bar[XB_TMO])) break; if (sp > XB_SPIN_CAP) { atomicAdd(&bar[XB_TMO], 1u); break; } }
    }
    nloc = mine > 0u ? mine : 1u; nx = cnt > 0u ? cnt : 1u;
}

__device__ __forceinline__ void xcd_barrier(const XcdBarrier& b) {
    asm volatile("s_waitcnt vmcnt(0)" ::: "memory");
    __syncthreads();
    if (threadIdx.x == 0) {
        unsigned* bar = b.bar;
        __builtin_amdgcn_s_waitcnt(0);
        unsigned nloc = b.st[0], nx = b.st[1];
        if (nloc == 0u) { xcd_barrier_complete(bar, b.x, nloc, nx); b.st[0] = nloc; b.st[1] = nx; }
        const unsigned old = xb_add(&bar[XB_XSUB(b.x)], 1u);
        const unsigned gen = old / nloc;
        if (old + 1u == (gen + 1u) * nloc) {
            __builtin_amdgcn_fence(__ATOMIC_RELEASE, "agent");
            asm volatile("s_waitcnt vmcnt(0)" ::: "memory");
            const unsigned og = xb_add(&bar[XB_TOP], 1u);
            const unsigned tg = og / nx;
            if (og + 1u == (tg + 1u) * nx) xb_add(&bar[XB_TOPGEN], 1u);
            else XB_SPIN(xb_ld(&bar[XB_TOPGEN]) == tg, bar);
            __builtin_amdgcn_fence(__ATOMIC_ACQUIRE, "agent");
            xb_add(&bar[XB_XGEN(b.x)], 1u);
            asm volatile("s_waitcnt vmcnt(0)" ::: "memory");
        } else {
            XB_SPIN(xb_ld(&bar[XB_XGEN(b.x)]) == gen, bar);
            __builtin_amdgcn_fence(__ATOMIC_ACQUIRE, "agent");
            asm volatile("s_waitcnt vmcnt(0)" ::: "memory");
        }
    }
    __syncthreads();
}
constexpr int NWAVES = 8;
constexpr int NB = 16, SEQ = 2048, DM = 1024, M = NB * SEQ;
constexpr int NPROJ = 5120, QKVW = 1536;
constexpr int NH = 4, HD = 64, VD = 128;
constexpr int SSMW = 512, NG = 32, GH = 16, NP = 64;
constexpr float EPS = 1e-6f, LOG2E = 1.4426950408889634f, QSCALE = 0.125f * LOG2E;
constexpr float LAM_INIT = 0.2f;
constexpr int KSL = 8;

constexpr size_t MiB = 1u << 20;
constexpr size_t WS_CTL = 0, CTL_ZERO_BYTES = 1 * MiB;
constexpr size_t WS_MODP = 1 * MiB;
constexpr size_t WS_GATE = 3 * MiB;
constexpr size_t WS_ROPE = 4 * MiB;
constexpr size_t WS_WIN = 6 * MiB, WS_WGLU = 16 * MiB, WS_WUPA = 17 * MiB, WS_WUPS = 18 * MiB, WS_WOUT = 19 * MiB;
constexpr size_t WS_SSMT = 22 * MiB;
constexpr size_t WS_H = 40 * MiB;
constexpr size_t WS_AIN = 40 * MiB, WS_Y = 72 * MiB;
constexpr size_t WS_QKV = 104 * MiB;
constexpr size_t WS_ZA = 200 * MiB, WS_U = 232 * MiB, WS_ZS = 264 * MiB;
constexpr size_t WS_Y2 = WS_U;
constexpr size_t WS_GA = 296 * MiB, WS_GS = 360 * MiB;
constexpr size_t WS_YTMP = 424 * MiB;
constexpr size_t WS_END = 488 * MiB;
constexpr int CW_TMO = 0, CW_BAR = 4096, CW_ROWSS = 65536;
static_assert((CW_ROWSS + M) * 4 <= (int)CTL_ZERO_BYTES, "ctl");

constexpr int RING_OFF = 0, RING_BYTES = 131072;
constexpr int LDSCTL_OFF = RING_BYTES, MISC_OFF = LDSCTL_OFF + 320;
constexpr int LDS_BYTES = 147456;
struct Frame {
    LAS unsigned char* lds;
    volatile LAS unsigned* MISC;
    gu32* ctl;
    int tid, lane, wave;
    int vcu, G;
    const float* in[23]; float* out; unsigned char* ws;
};
__device__ __forceinline__ float wave_sum(float v) {
#pragma unroll
    for (int o = 1; o < 64; o <<= 1) v += __shfl_xor(v, o);
    return v;
}
__device__ __forceinline__ float sigm(float x) { return __builtin_amdgcn_rcpf(1.0f + __builtin_amdgcn_exp2f(-LOG2E * x)); }
__device__ __forceinline__ float bflo(unsigned w) { return __uint_as_float(w << 16); }
__device__ __forceinline__ float bfhi(unsigned w) { return __uint_as_float(w & 0xffff0000u); }
__device__ __forceinline__ float sin_rev(float ang) { float r = ang * 0.15915494309189535f; r -= floorf(r); return __builtin_amdgcn_sinf(r); }
__device__ __forceinline__ float cos_rev(float ang) { float r = ang * 0.15915494309189535f; r -= floorf(r); return __builtin_amdgcn_cosf(r); }

__device__ __forceinline__ void p0_transpose_item(const float* W, int K, int N, bf16* WT, LAS float* scr, int item, int lane) {
    const int nblk = N / 32, kb = item / nblk, nb = item % nblk, k0 = 64 * kb, n0 = 32 * nb;
#pragma unroll 8
    for (int i = 0; i < 32; ++i) { const int kk = 2 * i + (lane >> 5); scr[kk * 33 + (lane & 31)] = W[(size_t)(k0 + kk) * N + n0 + (lane & 31)]; }
    LDS_WAIT(); asm volatile("" ::: "memory");
    const int c = lane & 7;
#pragma unroll
    for (int j = 0; j < 4; ++j) { const int n = (lane >> 3) + 8 * j; const LAS float* s = scr + (8 * c) * 33 + n;
        v4u o; o.x = pk2(s[0 * 33], s[1 * 33]); o.y = pk2(s[2 * 33], s[3 * 33]); o.z = pk2(s[4 * 33], s[5 * 33]); o.w = pk2(s[6 * 33], s[7 * 33]);
        *(GAS v4u*)(WT + (size_t)(n0 + n) * K + k0 + 8 * c) = o; }
    LDS_WAIT(); asm volatile("" ::: "memory");
}
__device__ __forceinline__ void p0_prologue(Frame& F) {
    LAS float* scr = (LAS float*)(F.lds + RING_OFF + F.wave * 16384);
    const int gw = F.vcu * NWAVES + F.wave, NGW = F.G * NWAVES;
    constexpr int I_IN = (DM / 64) * (NPROJ / 32), I_GLU = (512 / 64) * (512 / 32), I_UP = (512 / 64) * (DM / 32), I_OUT = (DM / 64) * (DM / 32);
    constexpr int I_MOD = 48 * KSL;
    constexpr int NITEMS = I_IN + I_GLU + 2 * I_UP + I_OUT + I_MOD;
    bf16* ws16 = (bf16*)F.ws;
    for (int it = gw; it < NITEMS; it += NGW) {
        int r = it;
        if (r < I_MOD) {
            const int cg = r / KSL, ks = r % KSL, n = cg * 64 + F.lane, k0 = ks * 128;
            const float* c = F.in[1]; const float* wa = F.in[3];
            for (int i = F.lane; i < 16 * 128; i += 64) { const int b = i >> 7, k = i & 127; const float cv = c[b * DM + k0 + k]; scr[i] = cv * sigm(cv); }
            LDS_WAIT(); asm volatile("" ::: "memory");
            float acc[16];
#pragma unroll
            for (int b = 0; b < 16; ++b) acc[b] = 0.f;
            for (int k = 0; k < 128; ++k) { const float w = wa[(size_t)(k0 + k) * 3072 + n];
#pragma unroll
                for (int b = 0; b < 16; ++b) acc[b] += scr[b * 128 + k] * w; }
            float* mp = (float*)(F.ws + WS_MODP) + (size_t)ks * 16 * 3072;
#pragma unroll
            for (int b = 0; b < 16; ++b) mp[b * 3072 + n] = acc[b];
            LDS_WAIT(); asm volatile("" ::: "memory");
            continue; }
        r -= I_MOD;
        if (r < I_IN) { p0_transpose_item(F.in[6], DM, NPROJ, ws16 + WS_WIN / 2, scr, r, F.lane); continue; } r -= I_IN;
        if (r < I_GLU) { p0_transpose_item(F.in[17], 512, 512, ws16 + WS_WGLU / 2, scr, r, F.lane); continue; } r -= I_GLU;
        if (r < I_UP) { p0_transpose_item(F.in[19], 512, DM, ws16 + WS_WUPA / 2, scr, r, F.lane); continue; } r -= I_UP;
        if (r < I_UP) { p0_transpose_item(F.in[20], 512, DM, ws16 + WS_WUPS / 2, scr, r, F.lane); continue; } r -= I_UP;
        p0_transpose_item(F.in[21], DM, DM, ws16 + WS_WOUT / 2, scr, r, F.lane);
    }
    { const int* pos = (const int*)F.in[2]; float* rope = (float*)(F.ws + WS_ROPE);
      for (int idx = (F.vcu * 512 + F.tid); idx < M * 8; idx += F.G * 512) { const int tok = idx >> 3, i = idx & 7;
          const float invf = __builtin_amdgcn_exp2f(-(float)i * (18.931568569324174f / 8.0f));
          const float ang = (float)pos[tok] * invf;
          rope[tok * 16 + i] = cos_rev(ang); rope[tok * 16 + 8 + i] = sin_rev(ang); } }
}

__device__ __forceinline__ void p1a_norm(Frame& F) {
    LAS float* gs = (LAS float*)(F.lds + RING_OFF); LAS float* sh = gs + 1024;
    const float* modp = (const float*)(F.ws + WS_MODP); const float* b_ada = F.in[4]; const float* g_pre = F.in[5];
    const int rows_per = M / F.G;
    const int r0 = F.vcu * rows_per, b = r0 / SEQ;
    for (int k = F.tid; k < 1024; k += 512) {
        float s_sh = b_ada[k], s_sc = b_ada[1024 + k];
#pragma unroll
        for (int ks = 0; ks < KSL; ++ks) { s_sh += modp[((size_t)ks * 16 + b) * 3072 + k]; s_sc += modp[((size_t)ks * 16 + b) * 3072 + 1024 + k]; }
        gs[k] = g_pre[k] * (1.0f + s_sc); sh[k] = s_sh; }
    { const int sub = (r0 % SEQ) / rows_per;
      if (F.tid < 64 && sub < 16) { const int k = sub * 64 + F.tid; float s = b_ada[2048 + k];
#pragma unroll
          for (int ks = 0; ks < KSL; ++ks) s += modp[((size_t)ks * 16 + b) * 3072 + 2048 + k];
          ((float*)(F.ws + WS_GATE))[b * 1024 + k] = s; } }
    LDS_WAIT(); __syncthreads();
    bf16* H = (bf16*)(F.ws + WS_H);
    for (int r = r0 + F.wave; r < r0 + rows_per; r += NWAVES) {
        const GAS f32x4* xr = (const GAS f32x4*)(F.in[0] + (size_t)r * DM) + F.lane;
        f32x4 v[4]; float s = 0.f;
#pragma unroll
        for (int j = 0; j < 4; ++j) { v[j] = xr[64 * j]; s += (v[j].x * v[j].x + v[j].y * v[j].y) + (v[j].z * v[j].z + v[j].w * v[j].w); }
        const float inv = 1.0f / sqrtf(wave_sum(s) * (1.f / DM) + EPS);
        GAS unsigned long long* o8 = (GAS unsigned long long*)(H + (size_t)r * DM) + F.lane;
#pragma unroll
        for (int j = 0; j < 4; ++j) { const int k = 4 * F.lane + 256 * j; const f32x4 g = *(const LAS f32x4*)(gs + k), s4 = *(const LAS f32x4*)(sh + k);
            const f32x4 h = v[j] * inv * g + s4;
            o8[64 * j] = (unsigned long long)pk2(h.x, h.y) | ((unsigned long long)pk2(h.z, h.w) << 32); }
    }
    __syncthreads();
}

__device__ __forceinline__ void attn_naive_unit(Frame& F, int unit) {
    const int qb = unit & 31, bh = unit >> 5, h = bh & 3, b = bh >> 2;
    const int t = F.tid, row = t & 63, c = (t >> 6) & 1, dq = t >> 7;
    const bf16* QKV = (const bf16*)(F.ws + WS_QKV);
    LAS unsigned char* Kl = F.lds + RING_OFF; LAS unsigned char* Vl = Kl + 8192; LAS float* X = (LAS float*)(F.lds + RING_OFF + 32768); LAS float* SS = X + 64 * 128;
    float q[64];
    { const v4u* qp = (const v4u*)(QKV + (size_t)(b * SEQ + qb * 64 + row) * QKVW + h * 128 + c * 64);
#pragma unroll
      for (int i = 0; i < 8; ++i) { const v4u w = qp[i]; q[8 * i] = bflo(w.x); q[8 * i + 1] = bfhi(w.x); q[8 * i + 2] = bflo(w.y); q[8 * i + 3] = bfhi(w.y);
          q[8 * i + 4] = bflo(w.z); q[8 * i + 5] = bfhi(w.z); q[8 * i + 6] = bflo(w.w); q[8 * i + 7] = bfhi(w.w); } }
    float o[32];
#pragma unroll
    for (int j = 0; j < 32; ++j) o[j] = 0.f;
    float mrun = -1e30f, l = 0.f;
    const int lk = t >> 4, lc = t & 15;
    for (int kt = 0; kt < SEQ / 32; ++kt) {
        __syncthreads();
        { const size_t rowoff = (size_t)(b * SEQ + kt * 32 + lk) * QKVW + h * 128 + lc * 8;
          *(LAS v4u*)(Kl + lk * 256 + lc * 16) = *(const v4u*)(QKV + rowoff + 512);
          *(LAS v4u*)(Vl + lk * 256 + lc * 16) = *(const v4u*)(QKV + rowoff + 1024); }
        LDS_WAIT(); __syncthreads();
#pragma unroll 1
        for (int key = 0; key < 32; ++key) {
            const LAS unsigned char* Kg = Kl + key * 256 + c * 128; const LAS unsigned char* Vg = Vl + key * 256 + dq * 64;
            float a = 0.f;
#pragma unroll
            for (int i = 0; i < 8; ++i) { const v4u w = *(const LAS v4u*)(Kg + i * 16);
                a += q[8 * i] * bflo(w.x) + q[8 * i + 1] * bfhi(w.x) + q[8 * i + 2] * bflo(w.y) + q[8 * i + 3] * bfhi(w.y)
                   + q[8 * i + 4] * bflo(w.z) + q[8 * i + 5] * bfhi(w.z) + q[8 * i + 6] * bflo(w.w) + q[8 * i + 7] * bfhi(w.w); }
            const float mn = fmaxf(mrun, a), alpha = __builtin_amdgcn_exp2f(mrun - mn), p = __builtin_amdgcn_exp2f(a - mn); mrun = mn;
            l = l * alpha + p;
#pragma unroll
            for (int i = 0; i < 4; ++i) { const v4u w = *(const LAS v4u*)(Vg + i * 16);
                o[8 * i] = o[8 * i] * alpha + p * bflo(w.x); o[8 * i + 1] = o[8 * i + 1] * alpha + p * bfhi(w.x); o[8 * i + 2] = o[8 * i + 2] * alpha + p * bflo(w.y); o[8 * i + 3] = o[8 * i + 3] * alpha + p * bfhi(w.y);
                o[8 * i + 4] = o[8 * i + 4] * alpha + p * bflo(w.z); o[8 * i + 5] = o[8 * i + 5] * alpha + p * bfhi(w.z); o[8 * i + 6] = o[8 * i + 6] * alpha + p * bflo(w.w); o[8 * i + 7] = o[8 * i + 7] * alpha + p * bfhi(w.w); }
        }
    }
    const float rl = 1.0f / l;
    float lam; { const float* lq = F.in[7]; float d1 = 0.f, d2 = 0.f; for (int i = 0; i < 64; ++i) { d1 += lq[i] * lq[64 + i]; d2 += lq[128 + i] * lq[192 + i]; } lam = __expf(d1) - __expf(d2) + LAM_INIT; }
    __syncthreads();
    if (c == 1) {
#pragma unroll
        for (int j = 0; j < 32; ++j) X[row * 128 + dq * 32 + j] = o[j] * rl; }
    LDS_WAIT(); __syncthreads();
    float ss = 0.f;
    if (c == 0) {
#pragma unroll
        for (int j = 0; j < 32; ++j) { o[j] = o[j] * rl - lam * X[row * 128 + dq * 32 + j]; ss += o[j] * o[j]; }
        SS[row * 4 + dq] = ss; }
    LDS_WAIT(); __syncthreads();
    if (c == 0) {
        const float inv = 1.0f / sqrtf(((SS[row * 4] + SS[row * 4 + 1]) + (SS[row * 4 + 2] + SS[row * 4 + 3])) * (1.0f / 128.0f) + EPS) * (1.0f - LAM_INIT);
        const float* gsub = F.in[8]; const size_t tok = (size_t)(b * SEQ + qb * 64 + row);
        const v4u* zp = (const v4u*)((const bf16*)(F.ws + WS_ZA) + tok * 512 + h * 128 + dq * 32);
        v4u* op = (v4u*)((bf16*)(F.ws + WS_AIN) + tok * 512 + h * 128 + dq * 32);
#pragma unroll
        for (int i = 0; i < 4; ++i) { const v4u z = zp[i]; float r[8];
#pragma unroll
            for (int e = 0; e < 8; ++e) r[e] = o[8 * i + e] * inv * gsub[dq * 32 + 8 * i + e];
            r[0] *= bflo(z.x); r[1] *= bfhi(z.x); r[2] *= bflo(z.y); r[3] *= bfhi(z.y); r[4] *= bflo(z.z); r[5] *= bfhi(z.z); r[6] *= bflo(z.w); r[7] *= bfhi(z.w);
            v4u w; w.x = pk2(r[0], r[1]); w.y = pk2(r[2], r[3]); w.z = pk2(r[4], r[5]); w.w = pk2(r[6], r[7]); op[i] = w; } }
    __syncthreads();
}

__device__ __forceinline__ float gelu_tanh(float x) { const float u = 0.7978845608028654f * (x + 0.044715f * x * x * x); const float e = __builtin_amdgcn_exp2f(2.0f * LOG2E * u); const float th = 1.0f - 2.0f * __builtin_amdgcn_rcpf(e + 1.0f); return 0.5f * x * (1.0f + th); }
__device__ __forceinline__ void ssm_naive_unit(Frame& F, int unit) {
    const int g = unit & 31, b = unit >> 5, p = F.lane;
    const bf16* U = (const bf16*)(F.ws + WS_U); float* YT = (float*)(F.ws + WS_YTMP); bf16* Y = (bf16*)(F.ws + WS_Y);
    const float* dsk = F.in[16];
    for (int d = 0; d < 2; ++d) {
        const int pg = (d * NG + g);
        const float dt = __expf(F.in[11][pg]);
        const float lr = fminf(F.in[9][pg * NP + p], -1e-4f), li = F.in[10][pg * NP + p];
        const float mag = __expf(lr * dt); const float are = mag * cos_rev(li * dt), aim = mag * sin_rev(li * dt);
        const float den = lr * lr + li * li, nr = are - 1.0f, ni = aim; const float cre_ = (nr * lr + ni * li) / den, cim_ = (ni * lr - nr * li) / den;
        float bre[16], bim[16], cre[16], cim[16];
#pragma unroll
        for (int h = 0; h < 16; ++h) { const float br = F.in[12][((size_t)pg * NP + p) * GH + h], bi = F.in[13][((size_t)pg * NP + p) * GH + h];
            bre[h] = cre_ * br - cim_ * bi; bim[h] = cre_ * bi + cim_ * br;
            cre[h] = F.in[14][((size_t)pg * GH + h) * NP + p]; cim[h] = F.in[15][((size_t)pg * GH + h) * NP + p]; }
        float xr = 0.f, xi = 0.f;
        const int hsel = ((p >> 5) & 1) * 8 + ((p >> 4) & 1) * 4 + ((p >> 3) & 1) * 2 + ((p >> 2) & 1);
        const float dv = dsk[g * GH + hsel];
        for (int st = 0; st < SEQ; ++st) {
            const int t = d ? (SEQ - 1 - st) : st; const size_t tok = (size_t)b * SEQ + t;
            const v4u* up = (const v4u*)(U + tok * SSMW + g * GH); const v4u w0 = up[0], w1 = up[1];
            float u[16]; u[0] = bflo(w0.x); u[1] = bfhi(w0.x); u[2] = bflo(w0.y); u[3] = bfhi(w0.y); u[4] = bflo(w0.z); u[5] = bfhi(w0.z); u[6] = bflo(w0.w); u[7] = bfhi(w0.w);
            u[8] = bflo(w1.x); u[9] = bfhi(w1.x); u[10] = bflo(w1.y); u[11] = bfhi(w1.y); u[12] = bflo(w1.z); u[13] = bfhi(w1.z); u[14] = bflo(w1.w); u[15] = bfhi(w1.w);
            float br = 0.f, bi = 0.f;
#pragma unroll
            for (int h = 0; h < 16; ++h) { br += bre[h] * u[h]; bi += bim[h] * u[h]; }
            const float nxr = are * xr - aim * xi + br, nxi = are * xi + aim * xr + bi; xr = nxr; xi = nxi;
            float v[16];
#pragma unroll
            for (int h = 0; h < 16; ++h) v[h] = cre[h] * xr - cim[h] * xi;
            float w8[8], w4[4], w2[2], w1_;
            { const bool hi = (p & 32) != 0;
#pragma unroll
              for (int k = 0; k < 8; ++k) { const float send = hi ? v[k] : v[k + 8], keep = hi ? v[k + 8] : v[k]; w8[k] = keep + __shfl_xor(send, 32); } }
            { const bool hi = (p & 16) != 0;
#pragma unroll
              for (int k = 0; k < 4; ++k) { const float send = hi ? w8[k] : w8[k + 4], keep = hi ? w8[k + 4] : w8[k]; w4[k] = keep + __shfl_xor(send, 16); } }
            { const bool hi = (p & 8) != 0;
#pragma unroll
              for (int k = 0; k < 2; ++k) { const float send = hi ? w4[k] : w4[k + 2], keep = hi ? w4[k + 2] : w4[k]; w2[k] = keep + __shfl_xor(send, 8); } }
            { const bool hi = (p & 4) != 0; const float send = hi ? w2[0] : w2[1], keep = hi ? w2[1] : w2[0]; w1_ = keep + __shfl_xor(send, 4); }
            w1_ += __shfl_xor(w1_, 2); w1_ += __shfl_xor(w1_, 1);
            if ((p & 3) == 0) {
                if (d == 0) YT[tok * SSMW + g * GH + hsel] = w1_;
                else { const float uh = __uint_as_float((unsigned)U[tok * SSMW + g * GH + hsel] << 16);
                       const float y = YT[tok * SSMW + g * GH + hsel] + w1_ + dv * uh; Y[tok * SSMW + g * GH + hsel] = (bf16)f2bf(gelu_tanh(y)); } }
        }
        asm volatile("s_waitcnt vmcnt(0)" ::: "memory");
    }
}

__device__ __forceinline__ void p6_final_norm(Frame& F) {
    const int gw = F.vcu * NWAVES + F.wave, NGW = F.G * NWAVES;
    const float* rowss = (const float*)(F.ctl + CW_ROWSS); const float* gf = F.in[22];
    f32x4 g4[4];
#pragma unroll
    for (int j = 0; j < 4; ++j) g4[j] = *(const f32x4*)(gf + 4 * F.lane + 256 * j);
    for (int r = gw; r < M; r += NGW) { const float inv = 1.0f / sqrtf(rowss[r] * (1.f / DM) + EPS);
        GAS f32x4* o = (GAS f32x4*)(F.out + (size_t)r * DM) + F.lane;
#pragma unroll
        for (int j = 0; j < 4; ++j) o[64 * j] = o[64 * j] * inv * g4[j]; }
}
#ifndef MK_N_LAUNCHES
#define MK_N_LAUNCHES 1
#endif
constexpr int N_PHASES = 9;
struct Args { const float* in[23]; float* out; unsigned char* ws; int ph_lo, ph_hi; };
__global__ void __launch_bounds__(NWAVES * 64, 2) fwd_kernel(Args args) {
    extern __shared__ __attribute__((aligned(16))) unsigned char lds[];
    Frame F;
    F.lds = (LAS unsigned char*)lds;
    F.MISC = (volatile LAS unsigned*)(F.lds + MISC_OFF);
    F.tid = threadIdx.x; F.lane = F.tid & 63; F.wave = __builtin_amdgcn_readfirstlane(F.tid >> 6);
    F.G = gridDim.x; { const int bx = blockIdx.x; F.vcu = (F.G % 8 == 0) ? (bx % 8) * (F.G / 8) + bx / 8 : bx; }
    F.ws = args.ws; F.out = args.out; F.ctl = (gu32*)(args.ws + WS_CTL);
#pragma unroll
    for (int i = 0; i < 23; ++i) F.in[i] = args.in[i];
    for (int u = F.tid; u < (LDS_BYTES - LDSCTL_OFF) / 4; u += NWAVES * 64) ((LAS unsigned*)(F.lds + LDSCTL_OFF))[u] = 0u;
    __syncthreads();
    const int lo = args.ph_lo, hi = args.ph_hi;
    const bool multi = (hi - lo) > 1;
    XcdBarrier bar; bar.bar = (unsigned*)(F.ctl + CW_BAR); bar.x = 0; bar.st = nullptr;
    if (multi) bar = xcd_barrier_post((unsigned*)(F.ctl + CW_BAR), F.MISC + 8);
#define IN(k) (lo <= (k) && (k) < hi)
#define SEAM(k) do { if (IN(k) && IN((k) + 1)) xcd_barrier(bar); } while (0)
    bf16* ws16 = (bf16*)args.ws;
    if (IN(0)) { p0_prologue(F); SEAM(0); }
    if (IN(1)) { p1a_norm(F); SEAM(1); }
    if (IN(2)) {
        pg8::Gemm g{ws16 + WS_H / 2, ws16 + WS_WIN / 2, M, NPROJ, DM}; pg8::StaticOrder S; S.init(M, NPROJ, F.G, (int)blockIdx.x);
        pg8::EpiProj E{ws16 + WS_QKV / 2, ws16 + WS_ZA / 2, ws16 + WS_U / 2, ws16 + WS_ZS / 2, ws16 + WS_GA / 2, ws16 + WS_GS / 2, (const float*)(args.ws + WS_ROPE), QSCALE};
        pg8::gemm_phase<pg8::EpiProj, pg8::StaticOrder, true, true>(F.lds + RING_OFF, g, S, E);
        SEAM(2); }
    if (IN(3)) {
        for (int u = F.vcu; u < NB * NH * 32; u += F.G) attn_naive_unit(F, u);
        { const int gw = F.vcu * NWAVES + F.wave; if ((gw & 3) == 0 && (gw >> 2) < NB * NG) ssm_naive_unit(F, gw >> 2); }
        SEAM(3); }
    if (IN(4)) {
        pg8::Gemm g{ws16 + WS_Y / 2, ws16 + WS_WGLU / 2, M, 512, 512}; pg8::StaticOrder S; S.init(M, 512, F.G, (int)blockIdx.x);
        pg8::EpiGlu E{ws16 + WS_Y / 2, ws16 + WS_ZS / 2, ws16 + WS_Y2 / 2, F.in[18]};
        pg8::gemm_phase<pg8::EpiGlu, pg8::StaticOrder, true, true>(F.lds + RING_OFF, g, S, E);
        SEAM(4); }
    if (IN(5)) {
        pg8::Gemm g{ws16 + WS_AIN / 2, ws16 + WS_WUPA / 2, M, DM, 512}; pg8::StaticOrder S; S.init(M, DM, F.G, (int)blockIdx.x);
        pg8::EpiMerge<0> E{ws16 + WS_GA / 2, nullptr};
        pg8::gemm_phase<pg8::EpiMerge<0>, pg8::StaticOrder, true, true>(F.lds + RING_OFF, g, S, E);
        SEAM(5); }
    if (IN(6)) {
        pg8::Gemm g{ws16 + WS_Y2 / 2, ws16 + WS_WUPS / 2, M, DM, 512}; pg8::StaticOrder S; S.init(M, DM, F.G, (int)blockIdx.x);
        pg8::EpiMerge<1> E{ws16 + WS_GA / 2, ws16 + WS_GS / 2};
        pg8::gemm_phase<pg8::EpiMerge<1>, pg8::StaticOrder, true, true>(F.lds + RING_OFF, g, S, E);
        SEAM(6); }
    if (IN(7)) {
        pg8::Gemm g{ws16 + WS_GA / 2, ws16 + WS_WOUT / 2, M, DM, DM}; pg8::StaticOrder S; S.init(M, DM, F.G, (int)blockIdx.x);
        pg8::EpiOut E{F.in[0], (const float*)(args.ws + WS_GATE), F.out, (float*)(F.ctl + CW_ROWSS)};
        pg8::gemm_phase<pg8::EpiOut, pg8::StaticOrder, true, true>(F.lds + RING_OFF, g, S, E);
        SEAM(7); }
    if (IN(8)) { p6_final_norm(F); }
#undef IN
#undef SEAM
}

extern "C" void kernel_launch(void* const* d_in, const int* in_sizes, int n_in, void* d_out, int out_size, void* d_ws, size_t ws_size, hipStream_t stream) {
    static int grid = 0;
    if (grid == 0) {
        if (n_in != 23 || in_sizes[0] != M * DM || out_size != M * DM || ws_size < WS_END) { fprintf(stderr, "kernel_launch: shape/workspace mismatch (n_in %d, in0 %d, out %d, ws %zu)\n", n_in, n_in > 0 ? in_sizes[0] : -1, out_size, ws_size); grid = -1; return; }
        if (hipFuncSetAttribute((const void*)fwd_kernel, hipFuncAttributeMaxDynamicSharedMemorySize, LDS_BYTES) != hipSuccess) { fprintf(stderr, "kernel_launch: hipFuncSetAttribute failed\n"); grid = -1; return; }
        int per_cu = 0;
        if (hipOccupancyMaxActiveBlocksPerMultiprocessor(&per_cu, (const void*)fwd_kernel, NWAVES * 64, LDS_BYTES) != hipSuccess || per_cu < 1) fprintf(stderr, "kernel_launch: occupancy query reports %d\n", per_cu);
        (void)hipGetLastError();
        grid = 256;
    }
    if (grid < 0) return;
    if (hipMemsetAsync((char*)d_ws + WS_CTL, 0, CTL_ZERO_BYTES, stream) != hipSuccess) { fprintf(stderr, "kernel_launch: memset failed\n"); return; }
    Args a{};
    for (int i = 0; i < 23; ++i) a.in[i] = (const float*)d_in[i];
    a.out = (float*)d_out; a.ws = (unsigned char*)d_ws;
    if (MK_N_LAUNCHES == 1) { a.ph_lo = 0; a.ph_hi = N_PHASES; hipLaunchKernelGGL(fwd_kernel, dim3(grid), dim3(NWAVES * 64), LDS_BYTES, stream, a); }
    else for (int p = 0; p < N_PHASES; ++p) { a.ph_lo = p; a.ph_hi = p + 1; hipLaunchKernelGGL(fwd_kernel, dim3(grid), dim3(NWAVES * 64), LDS_BYTES, stream, a); }
    const hipError_t le = hipPeekAtLastError();
    if (le != hipSuccess) fprintf(stderr, "kernel_launch: launch failed: %s\n", hipGetErrorName(le));
}
```

```cpp
#include <hip/hip_runtime.h>
#include <cstdio>
#include <cstdint>
namespace pg8 {
#define PG8_LAS __attribute__((address_space(3)))
typedef unsigned short bf16_t;
typedef short bf16x8 __attribute__((ext_vector_type(8)));
typedef float f32x4 __attribute__((ext_vector_type(4)));
typedef unsigned u32x4 __attribute__((ext_vector_type(4)));
constexpr int BM = 256, BK = 64, HALF = 128, HTB = HALF * BK * 2  , STAGE_BYTES = 8 * HTB, NXCD = 8, WGM = 8;

__host__ __device__ __forceinline__ int lds_byte(int r, int c) { const int st = (r >> 4) * 2 + (c >> 5), rr = r & 15, cc = c & 31, ob = rr * 64 + cc * 2; return st * 1024 + (ob ^ (((ob >> 9) & 1) << 5)); }
__host__ __device__ __forceinline__ void stage_rc(int b, int& R, int& C) { const int st = b / 1024, sb = b % 1024, swz = sb ^ (((sb >> 9) & 1) << 5); R = (st >> 1) * 16 + swz / 64; C = (st & 1) * 32 + (swz % 64) / 2; }
__host__ __device__ __forceinline__ int perm32(int rho) { const int n = rho >> 4, i = rho & 15; return 8 * (i >> 2) + 4 * n + (i & 3); }

struct Unit { int pm, pn; };
struct Gemm { const bf16_t* A; const bf16_t* Bt; int M, N, K; };

struct StaticOrder {
    int nM, nN, nwg, G, c;
    __host__ __device__ void init(int M, int N, int G_, int c_) { nM = M / BM; nN = N / BM; nwg = nM * nN; G = G_; c = c_; }
    __host__ __device__ bool next(int i, Unit& u) const {
        const long L = (long)i * G + c; if (L >= nwg) return false;
        int wgid = (int)L; { const int q = nwg / NXCD, r = nwg % NXCD, xcd = wgid % NXCD, off = wgid / NXCD; wgid = (xcd < r ? xcd * (q + 1) : r * (q + 1) + (xcd - r) * q) + off; }
        const int nig = WGM * nN, gid = wgid / nig, fm = gid * WGM, gsz = (nM - fm) < WGM ? (nM - fm) : WGM;
        u.pm = fm + ((wgid % nig) % gsz); u.pn = (wgid % nig) / gsz; return true;
    }
    __device__ __forceinline__ void a_ready(const Unit&) const {}
    __device__ __forceinline__ void done(const Unit&) const {}
};

__device__ __forceinline__ unsigned cvt_pk_bf16(float lo, float hi) { unsigned r; asm volatile("v_cvt_pk_bf16_f32 %0, %1, %2" : "=v"(r) : "v"(lo), "v"(hi)); return r; }
__device__ __forceinline__ float bf_lo(unsigned w) { return __uint_as_float(w << 16); }
__device__ __forceinline__ float bf_hi(unsigned w) { return __uint_as_float(w & 0xffff0000u); }
__device__ __forceinline__ float sigmoid_f(float x) { return __builtin_amdgcn_rcpf(1.0f + __builtin_amdgcn_exp2f(-1.4426950408889634f * x)); }
__device__ __forceinline__ void unpack8(const u32x4 w, float (&f)[8]) { f[0] = bf_lo(w.x); f[1] = bf_hi(w.x); f[2] = bf_lo(w.y); f[3] = bf_hi(w.y); f[4] = bf_lo(w.z); f[5] = bf_hi(w.z); f[6] = bf_lo(w.w); f[7] = bf_hi(w.w); }
__device__ __forceinline__ u32x4 pack8(const float (&f)[8]) { u32x4 w; w.x = cvt_pk_bf16(f[0], f[1]); w.y = cvt_pk_bf16(f[2], f[3]); w.z = cvt_pk_bf16(f[4], f[5]); w.w = cvt_pk_bf16(f[6], f[7]); return w; }

struct EpiProj {
    static constexpr bool PERM = true, AFTER_DRAIN = false;
    bf16_t *QKV, *ZA, *U, *ZS, *GA, *GS; const float* rope; float qscale;
    __device__ __forceinline__ void operator()(const f32x4 (&acc)[2][2][4][2], const Unit& u, int wr, int wc, int fr, int fq) const {
        const int pn = u.pn; bf16_t* base; int ldc, colt, act;
        float sc = 1.f;
        if (pn < 2)       { base = QKV; ldc = 1536; colt = pn * 256; act = 3; sc = qscale; }
        else if (pn < 4)  { base = QKV; ldc = 1536; colt = 512 + (pn - 2) * 256; act = 3; }
        else if (pn < 6)  { base = QKV; ldc = 1536; colt = 1024 + (pn - 4) * 256; act = 0; }
        else if (pn < 8)  { base = ZA; ldc = 512; colt = (pn - 6) * 256; act = 1; }
        else if (pn < 10) { base = U;  ldc = 512; colt = (pn - 8) * 256; act = 0; }
        else if (pn < 12) { base = ZS; ldc = 512; colt = (pn - 10) * 256; act = 1; }
        else if (pn < 16) { base = GA; ldc = 1024; colt = (pn - 12) * 256; act = 2; }
        else              { base = GS; ldc = 1024; colt = (pn - 16) * 256; act = 2; }
        const int row0 = u.pm * BM + wr * 64 + fr, col0 = colt + wc * 32 + 8 * fq;
        const bool rotw = (act == 3) && ((wc & 1) == 0);
#pragma unroll
        for (int ai = 0; ai < 2; ++ai)
#pragma unroll
            for (int m = 0; m < 4; ++m) {
                const int row = row0 + ai * HALF + m * 16; bf16_t* rowp = base + (size_t)row * ldc + col0;
                float cs[8], sn[8];
                if (rotw) { const f32x4* rp = (const f32x4*)(rope + (size_t)row * 16); const f32x4 c0 = rp[0], c1 = rp[1], s0 = rp[2], s1 = rp[3];
                    cs[0] = c0[0]; cs[1] = c0[1]; cs[2] = c0[2]; cs[3] = c0[3]; cs[4] = c1[0]; cs[5] = c1[1]; cs[6] = c1[2]; cs[7] = c1[3];
                    sn[0] = s0[0]; sn[1] = s0[1]; sn[2] = s0[2]; sn[3] = s0[3]; sn[4] = s1[0]; sn[5] = s1[1]; sn[6] = s1[2]; sn[7] = s1[3]; }
#pragma unroll
                for (int bj = 0; bj < 2; ++bj) {
                    float v[8];
#pragma unroll
                    for (int e = 0; e < 4; ++e) { v[e] = acc[ai][bj][m][0][e]; v[4 + e] = acc[ai][bj][m][1][e]; }
                    if (act == 1) {
#pragma unroll
                        for (int e = 0; e < 8; ++e) v[e] = v[e] * sigmoid_f(v[e]);
                    } else if (act == 2) {
#pragma unroll
                        for (int e = 0; e < 8; ++e) v[e] = sigmoid_f(v[e]);
                    } else if (act == 3) {
                        if (rotw) {
#pragma unroll
                            for (int e = 0; e < 8; ++e) { const float o = __shfl_xor(v[e], 16);
                                const float r1 = v[e] * cs[e] - o * sn[e], r2 = v[e] * cs[e] + o * sn[e];
                                v[e] = (fq == 0) ? r1 : ((fq == 1) ? r2 : v[e]); }
                        }
#pragma unroll
                        for (int e = 0; e < 8; ++e) v[e] *= sc;
                    }
                    *(u32x4*)(rowp + bj * HALF) = pack8(v);
                }
            }
    }
};
struct EpiGlu {
    static constexpr bool PERM = true, AFTER_DRAIN = false;
    const bf16_t *Y, *ZS; bf16_t* Y2; const float* bias;
    __device__ __forceinline__ void operator()(const f32x4 (&acc)[2][2][4][2], const Unit& u, int wr, int wc, int fr, int fq) const {
        const int row0 = u.pm * BM + wr * 64 + fr, col0 = u.pn * BM + wc * 32 + 8 * fq;
#pragma unroll
        for (int ai = 0; ai < 2; ++ai)
#pragma unroll
            for (int m = 0; m < 4; ++m) { const size_t off = (size_t)(row0 + ai * HALF + m * 16) * 512 + col0;
#pragma unroll
                for (int bj = 0; bj < 2; ++bj) {
                    const f32x4 b0 = *(const f32x4*)(bias + col0 + bj * HALF), b1 = *(const f32x4*)(bias + col0 + bj * HALF + 4);
                    float yv[8], zv[8], v[8]; unpack8(*(const u32x4*)(Y + off + bj * HALF), yv); unpack8(*(const u32x4*)(ZS + off + bj * HALF), zv);
#pragma unroll
                    for (int e = 0; e < 4; ++e) { v[e] = yv[e] * sigmoid_f(acc[ai][bj][m][0][e] + b0[e]) * zv[e]; v[4 + e] = yv[4 + e] * sigmoid_f(acc[ai][bj][m][1][e] + b1[e]) * zv[4 + e]; }
                    *(u32x4*)(Y2 + off + bj * HALF) = pack8(v);
                } }
    }
};
template <int MODE> struct EpiMerge {
    static constexpr bool PERM = true, AFTER_DRAIN = false;
    bf16_t* G; const bf16_t* G2;
    __device__ __forceinline__ void operator()(const f32x4 (&acc)[2][2][4][2], const Unit& u, int wr, int wc, int fr, int fq) const {
        const int row0 = u.pm * BM + wr * 64 + fr, col0 = u.pn * BM + wc * 32 + 8 * fq;
#pragma unroll
        for (int ai = 0; ai < 2; ++ai)
#pragma unroll
            for (int m = 0; m < 4; ++m) { const size_t off = (size_t)(row0 + ai * HALF + m * 16) * 1024 + col0;
#pragma unroll
                for (int bj = 0; bj < 2; ++bj) {
                    float g[8], v[8]; unpack8(*(const u32x4*)(G + off + bj * HALF), g);
                    if (MODE == 0) {
#pragma unroll
                        for (int e = 0; e < 4; ++e) { v[e] = g[e] * acc[ai][bj][m][0][e]; v[4 + e] = g[4 + e] * acc[ai][bj][m][1][e]; }
                    } else { float g2[8]; unpack8(*(const u32x4*)(G2 + off + bj * HALF), g2);
#pragma unroll
                        for (int e = 0; e < 4; ++e) { v[e] = g[e] + g2[e] * acc[ai][bj][m][0][e]; v[4 + e] = g[4 + e] + g2[4 + e] * acc[ai][bj][m][1][e]; }
                    }
                    *(u32x4*)(G + off + bj * HALF) = pack8(v);
                } }
    }
};
struct EpiOut {
    static constexpr bool PERM = true, AFTER_DRAIN = false;
    const float* x; const float* gate; float* out; float* rowss;
    __device__ __forceinline__ void operator()(const f32x4 (&acc)[2][2][4][2], const Unit& u, int wr, int wc, int fr, int fq) const {
        const int row0 = u.pm * BM + wr * 64 + fr, col0 = u.pn * BM + wc * 32 + 8 * fq;
        const float* gb = gate + (size_t)((u.pm * BM) >> 11) * 1024;
        f32x4 g[2][2];
#pragma unroll
        for (int bj = 0; bj < 2; ++bj) { g[bj][0] = *(const f32x4*)(gb + col0 + bj * HALF); g[bj][1] = *(const f32x4*)(gb + col0 + bj * HALF + 4); }
#pragma unroll
        for (int ai = 0; ai < 2; ++ai)
#pragma unroll
            for (int m = 0; m < 4; ++m) { const int row = row0 + ai * HALF + m * 16; const size_t off = (size_t)row * 1024 + col0; float ss = 0.f;
#pragma unroll
                for (int bj = 0; bj < 2; ++bj)
#pragma unroll
                    for (int n = 0; n < 2; ++n) { const f32x4 xv = *(const f32x4*)(x + off + bj * HALF + 4 * n); const f32x4 o = xv + g[bj][n] * acc[ai][bj][m][n];
                        *(f32x4*)(out + off + bj * HALF + 4 * n) = o; ss += (o[0] * o[0] + o[1] * o[1]) + (o[2] * o[2] + o[3] * o[3]); }
                ss += __shfl_xor(ss, 16); ss += __shfl_xor(ss, 32);
                if (fq == 0) atomicAdd(rowss + row, ss); }
    }
};

template <class Epi, class Sched, bool ALIGN_EPI = false, bool SP2 = false>
__device__ __forceinline__ void gemm_phase(PG8_LAS unsigned char* lds, const Gemm g, const Sched& S, const Epi& E) {
    const int tid = threadIdx.x, wid = __builtin_amdgcn_readfirstlane(tid >> 6), lane = tid & 63, wr = wid >> 2, wc = wid & 3, fr = lane & 15, fq = lane >> 4;
    const int K = g.K, nt = K / BK;
    unsigned voffA[2], voffB[2];
#pragma unroll
    for (int i = 0; i < 2; ++i) { int R, C; stage_rc(tid * 16 + i * 8192, R, C); const int Rb = Epi::PERM ? ((R & ~31) + perm32(R & 31)) : R;
        voffA[i] = (unsigned)(R * K + C) * 2u; voffB[i] = (unsigned)(Rb * K + C) * 2u; }
    const size_t kstep = (size_t)(BK * 2);
    const size_t hstep = (size_t)HALF * K * 2;
    const size_t tstep = 2 * hstep;
    const unsigned ldsw = (unsigned)wid * 1024u;
    const int aoff = lds_byte(wr * 64 + fr, fq * 8), boff = lds_byte(wc * 32 + fr, fq * 8);
#define PG8_SA(b, h) (((b) * 2 + (h)) * HTB)
#define PG8_SB(b, h) ((4 + (b) * 2 + (h)) * HTB)
#define PG8_STAGE(bufoff, gbase, voff) do { _Pragma("unroll") for (int _i = 0; _i < 2; ++_i) \
        __builtin_amdgcn_global_load_lds((const unsigned*)((const char*)(gbase) + (voff)[_i]), (PG8_LAS unsigned*)(lds + (bufoff) + ldsw + _i * 8192), 16, 0, 0); } while (0)
#define PG8_LDA(dst, b, h) do { _Pragma("unroll") for (int m = 0; m < 4; ++m) _Pragma("unroll") for (int k = 0; k < 2; ++k) dst[m][k] = *(const PG8_LAS bf16x8*)(lds + PG8_SA(b, h) + aoff + m * 2048 + k * 1024); } while (0)
#define PG8_LDB(dst, b, h) do { _Pragma("unroll") for (int n = 0; n < 2; ++n) _Pragma("unroll") for (int k = 0; k < 2; ++k) dst[n][k] = *(const PG8_LAS bf16x8*)(lds + PG8_SB(b, h) + boff + n * 2048 + k * 1024); } while (0)
#define PG8_MMA(ai, bj, At, Bt) do { __builtin_amdgcn_s_setprio(1); _Pragma("unroll") for (int m = 0; m < 4; ++m) _Pragma("unroll") for (int n = 0; n < 2; ++n) _Pragma("unroll") for (int k = 0; k < 2; ++k) \
        acc[ai][bj][m][n] = __builtin_amdgcn_mfma_f32_16x16x32_bf16(Bt[n][k], At[m][k], acc[ai][bj][m][n], 0, 0, 0); __builtin_amdgcn_s_setprio(0); } while (0)
#define PG8_WAIT_V(n) asm volatile("s_waitcnt vmcnt(" #n ")" ::: "memory")
#define PG8_WAIT_L(n) asm volatile("s_waitcnt lgkmcnt(" #n ")" ::: "memory")
#define PG8_BAR __builtin_amdgcn_s_barrier()
#define PG8_SCHED __builtin_amdgcn_sched_barrier(0)
    Unit cur, nxt; int ui = 0;
    if (!S.next(0, cur)) return;
    f32x4 acc[2][2][4][2];
#pragma unroll
    for (int a = 0; a < 2; ++a)
#pragma unroll
        for (int b = 0; b < 2; ++b)
#pragma unroll
            for (int m = 0; m < 4; ++m)
#pragma unroll
                for (int n = 0; n < 2; ++n) acc[a][b][m][n] = (f32x4){0.f, 0.f, 0.f, 0.f};
    bf16x8 At[4][2], B0[2][2], B1[2][2];
    const char* cA = (const char*)g.A + (size_t)cur.pm * tstep; const char* cB = (const char*)g.Bt + (size_t)cur.pn * tstep;
    S.a_ready(cur);
    if constexpr (SP2) {
        PG8_STAGE(PG8_SB(0, 0), cB, voffB); PG8_STAGE(PG8_SB(0, 1), cB + hstep, voffB); PG8_STAGE(PG8_SA(0, 0), cA, voffA); PG8_STAGE(PG8_SA(0, 1), cA + hstep, voffA);
        if (wr == 1) PG8_BAR;
        PG8_WAIT_V(2); PG8_BAR;
        PG8_STAGE(PG8_SB(1, 0), cB + kstep, voffB); PG8_STAGE(PG8_SA(1, 0), cA + kstep, voffA); PG8_STAGE(PG8_SB(1, 1), cB + hstep + kstep, voffB);
        PG8_WAIT_V(6); PG8_BAR;
    } else {
        PG8_STAGE(PG8_SB(0, 0), cB, voffB); PG8_STAGE(PG8_SA(0, 0), cA, voffA); PG8_STAGE(PG8_SB(0, 1), cB + hstep, voffB); PG8_STAGE(PG8_SA(0, 1), cA + hstep, voffA);
        if (wr == 1) PG8_BAR;
        PG8_WAIT_V(4); PG8_BAR;
        PG8_STAGE(PG8_SB(1, 0), cB + kstep, voffB); PG8_STAGE(PG8_SA(1, 0), cA + kstep, voffA); PG8_STAGE(PG8_SB(1, 1), cB + hstep + kstep, voffB);
        PG8_WAIT_V(6); PG8_BAR;
    }
    for (;;) {
        const bool has_next = S.next(ui + 1, nxt);
        const char* nA = has_next ? (const char*)g.A + (size_t)nxt.pm * tstep : cA; const char* nB = has_next ? (const char*)g.Bt + (size_t)nxt.pn * tstep : cB;
        for (int t = 0; t < nt; t += 2) {
            const bool last = (t == nt - 2);
            const char* a1 = cA + (size_t)(t + 1) * kstep;
            const char* a2 = last ? nA : cA + (size_t)(t + 2) * kstep; const char* b2 = last ? nB : cB + (size_t)(t + 2) * kstep;
            const char* a3 = a2 + kstep; const char* b3 = b2 + kstep;
            if (last && has_next) S.a_ready(nxt);
            if constexpr (SP2) {
            PG8_LDB(B0, 0, 0); PG8_LDB(B1, 0, 1); PG8_SCHED; PG8_LDA(At, 0, 0); PG8_STAGE(PG8_SA(1, 1), a1 + hstep, voffA);
            PG8_WAIT_V(8); PG8_WAIT_L(0); PG8_BAR; PG8_MMA(0, 0, At, B0); PG8_MMA(0, 1, At, B1); PG8_BAR; PG8_SCHED;
            PG8_LDA(At, 0, 1); PG8_STAGE(PG8_SB(0, 0), b2, voffB); PG8_STAGE(PG8_SB(0, 1), b2 + hstep, voffB); PG8_STAGE(PG8_SA(0, 0), a2, voffA);
            PG8_WAIT_V(8); PG8_WAIT_L(0); PG8_BAR; PG8_MMA(1, 0, At, B0); PG8_MMA(1, 1, At, B1); PG8_BAR; PG8_SCHED;
            PG8_LDB(B0, 1, 0); PG8_LDB(B1, 1, 1); PG8_SCHED; PG8_LDA(At, 1, 0); PG8_STAGE(PG8_SA(0, 1), a2 + hstep, voffA);
            PG8_WAIT_V(8); PG8_WAIT_L(0); PG8_BAR; PG8_MMA(0, 0, At, B0); PG8_MMA(0, 1, At, B1); PG8_BAR; PG8_SCHED;
            PG8_LDA(At, 1, 1); PG8_STAGE(PG8_SB(1, 0), b3, voffB); PG8_STAGE(PG8_SB(1, 1), b3 + hstep, voffB); PG8_STAGE(PG8_SA(1, 0), a3, voffA);
            PG8_WAIT_V(8); PG8_WAIT_L(0); PG8_BAR; PG8_MMA(1, 0, At, B0); PG8_MMA(1, 1, At, B1); PG8_BAR; PG8_SCHED;
            } else {
            PG8_LDB(B0, 0, 0); PG8_SCHED; PG8_LDA(At, 0, 0); PG8_STAGE(PG8_SA(1, 1), a1 + hstep, voffA);
            PG8_WAIT_L(8); PG8_BAR; PG8_WAIT_L(0); PG8_MMA(0, 0, At, B0); PG8_BAR; PG8_SCHED;
            PG8_LDB(B1, 0, 1); PG8_STAGE(PG8_SB(0, 0), b2, voffB);
            PG8_BAR; PG8_WAIT_L(0); PG8_MMA(0, 1, At, B1); PG8_BAR;
            PG8_LDA(At, 0, 1); PG8_STAGE(PG8_SA(0, 0), a2, voffA);
            PG8_BAR; PG8_WAIT_L(0); PG8_MMA(1, 0, At, B0); PG8_BAR; PG8_SCHED;
            PG8_STAGE(PG8_SB(0, 1), b2 + hstep, voffB);
            PG8_WAIT_V(6); PG8_BAR; PG8_MMA(1, 1, At, B1); PG8_BAR;
            PG8_LDB(B0, 1, 0); PG8_SCHED; PG8_LDA(At, 1, 0); PG8_STAGE(PG8_SA(0, 1), a2 + hstep, voffA);
            PG8_WAIT_L(8); PG8_BAR; PG8_WAIT_L(0); PG8_MMA(0, 0, At, B0); PG8_BAR; PG8_SCHED;
            PG8_LDB(B1, 1, 1); PG8_STAGE(PG8_SB(1, 0), b3, voffB);
            PG8_BAR; PG8_WAIT_L(0); PG8_MMA(0, 1, At, B1); PG8_BAR;
            PG8_LDA(At, 1, 1); PG8_STAGE(PG8_SA(1, 0), a3, voffA);
            PG8_BAR; PG8_WAIT_L(0); PG8_MMA(1, 0, At, B0); PG8_BAR; PG8_SCHED;
            PG8_STAGE(PG8_SB(1, 1), b3 + hstep, voffB);
            PG8_WAIT_V(6); PG8_BAR; PG8_MMA(1, 1, At, B1); PG8_BAR;
            }
        }
        if constexpr (ALIGN_EPI) { if (wr == 0) PG8_BAR; }
        if constexpr (!Epi::AFTER_DRAIN) { E(acc, cur, wr, wc, fr, fq); S.done(cur); }
        if (!has_next) break;
#pragma unroll
        for (int a = 0; a < 2; ++a)
#pragma unroll
            for (int b = 0; b < 2; ++b)
#pragma unroll
                for (int m = 0; m < 4; ++m)
#pragma unroll
                    for (int n = 0; n < 2; ++n) acc[a][b][m][n] = (f32x4){0.f, 0.f, 0.f, 0.f};
        cur = nxt; cA = nA; cB = nB; ++ui;
        if constexpr (ALIGN_EPI) { if (wr == 1) PG8_BAR; }
    }
    PG8_WAIT_V(0);
    if constexpr (!ALIGN_EPI) { if (wr == 0) PG8_BAR; }
    PG8_BAR;
    if constexpr (Epi::AFTER_DRAIN) { E.fused(acc, cur, wr, wc, fr, fq, lds, wid, lane); S.done(cur); }
#undef PG8_SA
#undef PG8_SB
#undef PG8_STAGE
#undef PG8_LDA
#undef PG8_LDB
#undef PG8_MMA
#undef PG8_WAIT_V
#undef PG8_WAIT_L
#undef PG8_BAR
#undef PG8_SCHED
}
}
#define GAS __attribute__((address_space(1)))
#define LAS __attribute__((address_space(3)))
typedef unsigned short bf16;
typedef unsigned v4u __attribute__((ext_vector_type(4)));
typedef float f32x4 __attribute__((ext_vector_type(4)));
typedef short bf16x8 __attribute__((ext_vector_type(8)));
typedef GAS unsigned gu32;
typedef GAS unsigned long long gu64;
#define RLX_AGENT __ATOMIC_RELAXED, __HIP_MEMORY_SCOPE_AGENT
#define LDS_WAIT() asm volatile("s_waitcnt lgkmcnt(0)" ::: "memory")
#define VM_WAIT() asm volatile("s_waitcnt vmcnt(0)" ::: "memory")
__device__ __forceinline__ unsigned long long rt() { return __builtin_amdgcn_s_memrealtime(); }
__device__ __forceinline__ unsigned f2bf(float f) { unsigned u = __builtin_bit_cast(unsigned, f); return (u + 0x7fffu + ((u >> 16) & 1u)) >> 16; }
__device__ __forceinline__ unsigned pk2(float lo, float hi) { return f2bf(lo) | (f2bf(hi) << 16); }

#define XB_TMO      128
#define XB_XCNT(j)  (256  + 64 * (j))
#define XB_XSUB(j)  (1280 + 64 * (j))
#define XB_XGEN(j)  (2304 + 64 * (j))
#define XB_TOP      3328
#define XB_TOPGEN   3392
#define XCD_BAR_WORDS 3456
#define XB_SPIN_CAP (1u << 18)

__device__ __forceinline__ unsigned xb_ld(unsigned* p)              { return __hip_atomic_load(p, __ATOMIC_RELAXED, __HIP_MEMORY_SCOPE_AGENT); }
__device__ __forceinline__ unsigned xb_add(unsigned* p, unsigned v) { return __hip_atomic_fetch_add(p, v, __ATOMIC_RELAXED, __HIP_MEMORY_SCOPE_AGENT); }
__device__ __forceinline__ unsigned xb_xcc_id() { return (unsigned)__builtin_amdgcn_s_getreg((3 << 11) | 20) & 0xFu; }
#define XB_SPIN(cond, bar) do { unsigned _sp = 0; while (cond) { __builtin_amdgcn_s_sleep(1); \
    if ((++_sp & 255u) == 0u) { if (xb_ld(&(bar)[XB_TMO])) break; if (_sp > XB_SPIN_CAP) { atomicAdd(&(bar)[XB_TMO], 1u); break; } } } } while (0)

struct XcdBarrier {
    unsigned* bar; unsigned x;
    volatile LAS unsigned* st;
};

__device__ __forceinline__ XcdBarrier xcd_barrier_post(unsigned* bar, volatile LAS unsigned* st) {
    XcdBarrier b; b.bar = bar; b.x = xb_xcc_id(); b.st = st;
    if (threadIdx.x == 0) (void)xb_add(&bar[XB_XCNT(b.x)], 1u);
    return b;
}
__device__ __forceinline__ void xcd_barrier_complete(unsigned* bar, unsigned x, unsigned& nloc, unsigned& nx) {
    const unsigned G = gridDim.x * gridDim.y * gridDim.z;
    unsigned sum, cnt, mine, sp = 0u;
    for (;;) {
        sum = 0u; cnt = 0u; mine = 0u;
#pragma unroll
        for (unsigned j = 0; j < 16; ++j) { const unsigned c = xb_ld(&bar[XB_XCNT(j)]); sum += c; cnt += (c > 0u) ? 1u : 0u; mine = (j == x) ? c : mine; }
        if (sum == G) break;
        __builtin_amdgcn_s_sleep(1);
        if ((++sp & 255u) == 0u) { if (xb_ld(&bar[XB_TMO])) break; if (sp > XB_SPIN_CAP) { atomicAdd(&bar[XB_TMO], 1u); break; } }
    }
    nloc = mine > 0u ? mine : 1u; nx = cnt > 0u ? cnt : 1u;
}

__device__ __forceinline__ void xcd_barrier(const XcdBarrier& b) {
    asm volatile("s_waitcnt vmcnt(0)" ::: "memory");
    __syncthreads();
    if (threadIdx.x == 0) {
        unsigned* bar = b.bar;
        __builtin_amdgcn_s_waitcnt(0);
        unsigned nloc = b.st[0], nx = b.st[1];
        if (nloc == 0u) { xcd_barrier_complete(bar, b.x, nloc, nx); b.st[0] = nloc; b.st[1] = nx; }
        const unsigned old = xb_add(&bar[XB_XSUB(b.x)], 1u);
        const unsigned gen = old / nloc;
        if (old + 1u == (gen + 1u) * nloc) {
            __builtin_amdgcn_fence(__ATOMIC_RELEASE, "agent");
            asm volatile("s_waitcnt vmcnt(0)" ::: "memory");
            const unsigned og = xb_add(&bar[XB_TOP], 1u);
            const unsigned tg = og / nx;
            if (og + 1u == (tg + 1u) * nx) xb_add(&bar[XB_TOPGEN], 1u);
            else XB_SPIN(xb_ld(&bar[XB_TOPGEN]) == tg, bar);
            __builtin_amdgcn_fence(__ATOMIC_ACQUIRE, "agent");
            xb_add(&bar[XB_XGEN(b.x)], 1u);
            asm volatile("s_waitcnt vmcnt(0)" ::: "memory");
        } else {
            XB_SPIN(xb_ld(&bar[XB_XGEN(b.x)]) == gen, bar);
            __builtin_amdgcn_fence(__ATOMIC_ACQUIRE, "agent");
            asm volatile("s_waitcnt vmcnt(0)" ::: "memory");
        }
    }
    __syncthreads();
}
constexpr int NWAVES = 8;
constexpr int NB = 16, SEQ = 2048, DM = 1024, M = NB * SEQ;
constexpr int NPROJ = 5120, QKVW = 1536;
constexpr int NH = 4, HD = 64, VD = 128;
constexpr int SSMW = 512, NG = 32, GH = 16, NP = 64;
constexpr float EPS = 1e-6f, LOG2E = 1.4426950408889634f, QSCALE = 0.125f * LOG2E;
constexpr float LAM_INIT = 0.2f;
constexpr int KSL = 8;

constexpr size_t MiB = 1u << 20;
constexpr size_t WS_CTL = 0, CTL_ZERO_BYTES = 1 * MiB;
constexpr size_t WS_MODP = 1 * MiB;
constexpr size_t WS_GATE = 3 * MiB;
constexpr size_t WS_ROPE = 4 * MiB;
constexpr size_t WS_WIN = 6 * MiB, WS_WGLU = 16 * MiB, WS_WUPA = 17 * MiB, WS_WUPS = 18 * MiB, WS_WOUT = 19 * MiB;
constexpr size_t WS_SSMT = 22 * MiB;
constexpr size_t WS_H = 40 * MiB;
constexpr size_t WS_AIN = 40 * MiB, WS_Y = 72 * MiB;
constexpr size_t WS_QKV = 104 * MiB;
constexpr size_t WS_ZA = 200 * MiB, WS_U = 232 * MiB, WS_ZS = 264 * MiB;
constexpr size_t WS_Y2 = WS_U;
constexpr size_t WS_GA = 296 * MiB, WS_GS = 360 * MiB;
constexpr size_t WS_YTMP = 424 * MiB;
constexpr size_t WS_END = 488 * MiB;
constexpr int CW_TMO = 0, CW_BAR = 4096, CW_ROWSS = 65536;
static_assert((CW_ROWSS + M) * 4 <= (int)CTL_ZERO_BYTES, "ctl");

constexpr int RING_OFF = 0, RING_BYTES = 131072;
constexpr int LDSCTL_OFF = RING_BYTES, MISC_OFF = LDSCTL_OFF + 320;
constexpr int LDS_BYTES = 147456;
struct Frame {
    LAS unsigned char* lds;
    volatile LAS unsigned* MISC;
    gu32* ctl;
    int tid, lane, wave;
    int vcu, G;
    const float* in[23]; float* out; unsigned char* ws;
};
__device__ __forceinline__ float wave_sum(float v) {
#pragma unroll
    for (int o = 1; o < 64; o <<= 1) v += __shfl_xor(v, o);
    return v;
}
__device__ __forceinline__ float sigm(float x) { return __builtin_amdgcn_rcpf(1.0f + __builtin_amdgcn_exp2f(-LOG2E * x)); }
__device__ __forceinline__ float bflo(unsigned w) { return __uint_as_float(w << 16); }
__device__ __forceinline__ float bfhi(unsigned w) { return __uint_as_float(w & 0xffff0000u); }
__device__ __forceinline__ float sin_rev(float ang) { float r = ang * 0.15915494309189535f; r -= floorf(r); return __builtin_amdgcn_sinf(r); }
__device__ __forceinline__ float cos_rev(float ang) { float r = ang * 0.15915494309189535f; r -= floorf(r); return __builtin_amdgcn_cosf(r); }

__device__ __forceinline__ void p0_transpose_item(const float* W, int K, int N, bf16* WT, LAS float* scr, int item, int lane) {
    const int nblk = N / 32, kb = item / nblk, nb = item % nblk, k0 = 64 * kb, n0 = 32 * nb;
#pragma unroll 8
    for (int i = 0; i < 32; ++i) { const int kk = 2 * i + (lane >> 5); scr[kk * 33 + (lane & 31)] = W[(size_t)(k0 + kk) * N + n0 + (lane & 31)]; }
    LDS_WAIT(); asm volatile("" ::: "memory");
    const int c = lane & 7;
#pragma unroll
    for (int j = 0; j < 4; ++j) { const int n = (lane >> 3) + 8 * j; const LAS float* s = scr + (8 * c) * 33 + n;
        v4u o; o.x = pk2(s[0 * 33], s[1 * 33]); o.y = pk2(s[2 * 33], s[3 * 33]); o.z = pk2(s[4 * 33], s[5 * 33]); o.w = pk2(s[6 * 33], s[7 * 33]);
        *(GAS v4u*)(WT + (size_t)(n0 + n) * K + k0 + 8 * c) = o; }
    LDS_WAIT(); asm volatile("" ::: "memory");
}
__device__ __forceinline__ void p0_prologue(Frame& F) {
    LAS float* scr = (LAS float*)(F.lds + RING_OFF + F.wave * 16384);
    const int gw = F.vcu * NWAVES + F.wave, NGW = F.G * NWAVES;
    constexpr int I_IN = (DM / 64) * (NPROJ / 32), I_GLU = (512 / 64) * (512 / 32), I_UP = (512 / 64) * (DM / 32), I_OUT = (DM / 64) * (DM / 32);
    constexpr int I_MOD = 48 * KSL;
    constexpr int NITEMS = I_IN + I_GLU + 2 * I_UP + I_OUT + I_MOD;
    bf16* ws16 = (bf16*)F.ws;
    for (int it = gw; it < NITEMS; it += NGW) {
        int r = it;
        if (r < I_MOD) {
            const int cg = r / KSL, ks = r % KSL, n = cg * 64 + F.lane, k0 = ks * 128;
            const float* c = F.in[1]; const float* wa = F.in[3];
            for (int i = F.lane; i < 16 * 128; i += 64) { const int b = i >> 7, k = i & 127; const float cv = c[b * DM + k0 + k]; scr[i] = cv * sigm(cv); }
            LDS_WAIT(); asm volatile("" ::: "memory");
            float acc[16];
#pragma unroll
            for (int b = 0; b < 16; ++b) acc[b] = 0.f;
            for (int k = 0; k < 128; ++k) { const float w = wa[(size_t)(k0 + k) * 3072 + n];
#pragma unroll
                for (int b = 0; b < 16; ++b) acc[b] += scr[b * 128 + k] * w; }
            float* mp = (float*)(F.ws + WS_MODP) + (size_t)ks * 16 * 3072;
#pragma unroll
            for (int b = 0; b < 16; ++b) mp[b * 3072 + n] = acc[b];
            LDS_WAIT(); asm volatile("" ::: "memory");
            continue; }
        r -= I_MOD;
        if (r < I_IN) { p0_transpose_item(F.in[6], DM, NPROJ, ws16 + WS_WIN / 2, scr, r, F.lane); continue; } r -= I_IN;
        if (r < I_GLU) { p0_transpose_item(F.in[17], 512, 512, ws16 + WS_WGLU / 2, scr, r, F.lane); continue; } r -= I_GLU;
        if (r < I_UP) { p0_transpose_item(F.in[19], 512, DM, ws16 + WS_WUPA / 2, scr, r, F.lane); continue; } r -= I_UP;
        if (r < I_UP) { p0_transpose_item(F.in[20], 512, DM, ws16 + WS_WUPS / 2, scr, r, F.lane); continue; } r -= I_UP;
        p0_transpose_item(F.in[21], DM, DM, ws16 + WS_WOUT / 2, scr, r, F.lane);
    }
    { const int* pos = (const int*)F.in[2]; float* rope = (float*)(F.ws + WS_ROPE);
      for (int idx = (F.vcu * 512 + F.tid); idx < M * 8; idx += F.G * 512) { const int tok = idx >> 3, i = idx & 7;
          const float invf = __builtin_amdgcn_exp2f(-(float)i * (18.931568569324174f / 8.0f));
          const float ang = (float)pos[tok] * invf;
          rope[tok * 16 + i] = cos_rev(ang); rope[tok * 16 + 8 + i] = sin_rev(ang); } }
}

__device__ __forceinline__ void p1a_norm(Frame& F) {
    LAS float* gs = (LAS float*)(F.lds + RING_OFF); LAS float* sh = gs + 1024;
    const float* modp = (const float*)(F.ws + WS_MODP); const float* b_ada = F.in[4]; const float* g_pre = F.in[5];
    const int rows_per = M / F.G;
    const int r0 = F.vcu * rows_per, b = r0 / SEQ;
    for (int k = F.tid; k < 1024; k += 512) {
        float s_sh = b_ada[k], s_sc = b_ada[1024 + k];
#pragma unroll
        for (int ks = 0; ks < KSL; ++ks) { s_sh += modp[((size_t)ks * 16 + b) * 3072 + k]; s_sc += modp[((size_t)ks * 16 + b) * 3072 + 1024 + k]; }
        gs[k] = g_pre[k] * (1.0f + s_sc); sh[k] = s_sh; }
    { const int sub = (r0 % SEQ) / rows_per;
      if (F.tid < 64 && sub < 16) { const int k = sub * 64 + F.tid; float s = b_ada[2048 + k];
#pragma unroll
          for (int ks = 0; ks < KSL; ++ks) s += modp[((size_t)ks * 16 + b) * 3072 + 2048 + k];
          ((float*)(F.ws + WS_GATE))[b * 1024 + k] = s; } }
    LDS_WAIT(); __syncthreads();
    bf16* H = (bf16*)(F.ws + WS_H);
    for (int r = r0 + F.wave; r < r0 + rows_per; r += NWAVES) {
        const GAS f32x4* xr = (const GAS f32x4*)(F.in[0] + (size_t)r * DM) + F.lane;
        f32x4 v[4]; float s = 0.f;
#pragma unroll
        for (int j = 0; j < 4; ++j) { v[j] = xr[64 * j]; s += (v[j].x * v[j].x + v[j].y * v[j].y) + (v[j].z * v[j].z + v[j].w * v[j].w); }
        const float inv = 1.0f / sqrtf(wave_sum(s) * (1.f / DM) + EPS);
        GAS unsigned long long* o8 = (GAS unsigned long long*)(H + (size_t)r * DM) + F.lane;
#pragma unroll
        for (int j = 0; j < 4; ++j) { const int k = 4 * F.lane + 256 * j; const f32x4 g = *(const LAS f32x4*)(gs + k), s4 = *(const LAS f32x4*)(sh + k);
            const f32x4 h = v[j] * inv * g + s4;
            o8[64 * j] = (unsigned long long)pk2(h.x, h.y) | ((unsigned long long)pk2(h.z, h.w) << 32); }
    }
    __syncthreads();
}

__device__ __forceinline__ void attn_naive_unit(Frame& F, int unit) {
    const int qb = unit & 31, bh = unit >> 5, h = bh & 3, b = bh >> 2;
    const int t = F.tid, row = t & 63, c = (t >> 6) & 1, dq = t >> 7;
    const bf16* QKV = (const bf16*)(F.ws + WS_QKV);
    LAS unsigned char* Kl = F.lds + RING_OFF; LAS unsigned char* Vl = Kl + 8192; LAS float* X = (LAS float*)(F.lds + RING_OFF + 32768); LAS float* SS = X + 64 * 128;
    float q[64];
    { const v4u* qp = (const v4u*)(QKV + (size_t)(b * SEQ + qb * 64 + row) * QKVW + h * 128 + c * 64);
#pragma unroll
      for (int i = 0; i < 8; ++i) { const v4u w = qp[i]; q[8 * i] = bflo(w.x); q[8 * i + 1] = bfhi(w.x); q[8 * i + 2] = bflo(w.y); q[8 * i + 3] = bfhi(w.y);
          q[8 * i + 4] = bflo(w.z); q[8 * i + 5] = bfhi(w.z); q[8 * i + 6] = bflo(w.w); q[8 * i + 7] = bfhi(w.w); } }
    float o[32];
#pragma unroll
    for (int j = 0; j < 32; ++j) o[j] = 0.f;
    float mrun = -1e30f, l = 0.f;
    const int lk = t >> 4, lc = t & 15;
    for (int kt = 0; kt < SEQ / 32; ++kt) {
        __syncthreads();
        { const size_t rowoff = (size_t)(b * SEQ + kt * 32 + lk) * QKVW + h * 128 + lc * 8;
          *(LAS v4u*)(Kl + lk * 256 + lc * 16) = *(const v4u*)(QKV + rowoff + 512);
          *(LAS v4u*)(Vl + lk * 256 + lc * 16) = *(const v4u*)(QKV + rowoff + 1024); }
        LDS_WAIT(); __syncthreads();
#pragma unroll 1
        for (int key = 0; key < 32; ++key) {
            const LAS unsigned char* Kg = Kl + key * 256 + c * 128; const LAS unsigned char* Vg = Vl + key * 256 + dq * 64;
            float a = 0.f;
#pragma unroll
            for (int i = 0; i < 8; ++i) { const v4u w = *(const LAS v4u*)(Kg + i * 16);
                a += q[8 * i] * bflo(w.x) + q[8 * i + 1] * bfhi(w.x) + q[8 * i + 2] * bflo(w.y) + q[8 * i + 3] * bfhi(w.y)
                   + q[8 * i + 4] * bflo(w.z) + q[8 * i + 5] * bfhi(w.z) + q[8 * i + 6] * bflo(w.w) + q[8 * i + 7] * bfhi(w.w); }
            const float mn = fmaxf(mrun, a), alpha = __builtin_amdgcn_exp2f(mrun - mn), p = __builtin_amdgcn_exp2f(a - mn); mrun = mn;
            l = l * alpha + p;
#pragma unroll
            for (int i = 0; i < 4; ++i) { const v4u w = *(const LAS v4u*)(Vg + i * 16);
                o[8 * i] = o[8 * i] * alpha + p * bflo(w.x); o[8 * i + 1] = o[8 * i + 1] * alpha + p * bfhi(w.x); o[8 * i + 2] = o[8 * i + 2] * alpha + p * bflo(w.y); o[8 * i + 3] = o[8 * i + 3] * alpha + p * bfhi(w.y);
                o[8 * i + 4] = o[8 * i + 4] * alpha + p * bflo(w.z); o[8 * i + 5] = o[8 * i + 5] * alpha + p * bfhi(w.z); o[8 * i + 6] = o[8 * i + 6] * alpha + p * bflo(w.w); o[8 * i + 7] = o[8 * i + 7] * alpha + p * bfhi(w.w); }
        }
    }
    const float rl = 1.0f / l;
    float lam; { const float* lq = F.in[7]; float d1 = 0.f, d2 = 0.f; for (int i = 0; i < 64; ++i) { d1 += lq[i] * lq[64 + i]; d2 += lq[128 + i] * lq[192 + i]; } lam = __expf(d1) - __expf(d2) + LAM_INIT; }
    __syncthreads();
    if (c == 1) {
#pragma unroll
        for (int j = 0; j < 32; ++j) X[row * 128 + dq * 32 + j] = o[j] * rl; }
    LDS_WAIT(); __syncthreads();
    float ss = 0.f;
    if (c == 0) {
#pragma unroll
        for (int j = 0; j < 32; ++j) { o[j] = o[j] * rl - lam * X[row * 128 + dq * 32 + j]; ss += o[j] * o[j]; }
        SS[row * 4 + dq] = ss; }
    LDS_WAIT(); __syncthreads();
    if (c == 0) {
        const float inv = 1.0f / sqrtf(((SS[row * 4] + SS[row * 4 + 1]) + (SS[row * 4 + 2] + SS[row * 4 + 3])) * (1.0f / 128.0f) + EPS) * (1.0f - LAM_INIT);
        const float* gsub = F.in[8]; const size_t tok = (size_t)(b * SEQ + qb * 64 + row);
        const v4u* zp = (const v4u*)((const bf16*)(F.ws + WS_ZA) + tok * 512 + h * 128 + dq * 32);
        v4u* op = (v4u*)((bf16*)(F.ws + WS_AIN) + tok * 512 + h * 128 + dq * 32);
#pragma unroll
        for (int i = 0; i < 4; ++i) { const v4u z = zp[i]; float r[8];
#pragma unroll
            for (int e = 0; e < 8; ++e) r[e] = o[8 * i + e] * inv * gsub[dq * 32 + 8 * i + e];
            r[0] *= bflo(z.x); r[1] *= bfhi(z.x); r[2] *= bflo(z.y); r[3] *= bfhi(z.y); r[4] *= bflo(z.z); r[5] *= bfhi(z.z); r[6] *= bflo(z.w); r[7] *= bfhi(z.w);
            v4u w; w.x = pk2(r[0], r[1]); w.y = pk2(r[2], r[3]); w.z = pk2(r[4], r[5]); w.w = pk2(r[6], r[7]); op[i] = w; } }
    __syncthreads();
}

__device__ __forceinline__ float gelu_tanh(float x) { const float u = 0.7978845608028654f * (x + 0.044715f * x * x * x); const float e = __builtin_amdgcn_exp2f(2.0f * LOG2E * u); const float th = 1.0f - 2.0f * __builtin_amdgcn_rcpf(e + 1.0f); return 0.5f * x * (1.0f + th); }
__device__ __forceinline__ void ssm_naive_unit(Frame& F, int unit) {
    const int g = unit & 31, b = unit >> 5, p = F.lane;
    const bf16* U = (const bf16*)(F.ws + WS_U); float* YT = (float*)(F.ws + WS_YTMP); bf16* Y = (bf16*)(F.ws + WS_Y);
    const float* dsk = F.in[16];
    for (int d = 0; d < 2; ++d) {
        const int pg = (d * NG + g);
        const float dt = __expf(F.in[11][pg]);
        const float lr = fminf(F.in[9][pg * NP + p], -1e-4f), li = F.in[10][pg * NP + p];
        const float mag = __expf(lr * dt); const float are = mag * cos_rev(li * dt), aim = mag * sin_rev(li * dt);
        const float den = lr * lr + li * li, nr = are - 1.0f, ni = aim; const float cre_ = (nr * lr + ni * li) / den, cim_ = (ni * lr - nr * li) / den;
        float bre[16], bim[16], cre[16], cim[16];
#pragma unroll
        for (int h = 0; h < 16; ++h) { const float br = F.in[12][((size_t)pg * NP + p) * GH + h], bi = F.in[13][((size_t)pg * NP + p) * GH + h];
            bre[h] = cre_ * br - cim_ * bi; bim[h] = cre_ * bi + cim_ * br;
            cre[h] = F.in[14][((size_t)pg * GH + h) * NP + p]; cim[h] = F.in[15][((size_t)pg * GH + h) * NP + p]; }
        float xr = 0.f, xi = 0.f;
        const int hsel = ((p >> 5) & 1) * 8 + ((p >> 4) & 1) * 4 + ((p >> 3) & 1) * 2 + ((p >> 2) & 1);
        const float dv = dsk[g * GH + hsel];
        for (int st = 0; st < SEQ; ++st) {
            const int t = d ? (SEQ - 1 - st) : st; const size_t tok = (size_t)b * SEQ + t;
            const v4u* up = (const v4u*)(U + tok * SSMW + g * GH); const v4u w0 = up[0], w1 = up[1];
            float u[16]; u[0] = bflo(w0.x); u[1] = bfhi(w0.x); u[2] = bflo(w0.y); u[3] = bfhi(w0.y); u[4] = bflo(w0.z); u[5] = bfhi(w0.z); u[6] = bflo(w0.w); u[7] = bfhi(w0.w);
            u[8] = bflo(w1.x); u[9] = bfhi(w1.x); u[10] = bflo(w1.y); u[11] = bfhi(w1.y); u[12] = bflo(w1.z); u[13] = bfhi(w1.z); u[14] = bflo(w1.w); u[15] = bfhi(w1.w);
            float br = 0.f, bi = 0.f;
#pragma unroll
            for (int h = 0; h < 16; ++h) { br += bre[h] * u[h]; bi += bim[h] * u[h]; }
            const float nxr = are * xr - aim * xi + br, nxi = are * xi + aim * xr + bi; xr = nxr; xi = nxi;
            float v[16];
#pragma unroll
            for (int h = 0; h < 16; ++h) v[h] = cre[h] * xr - cim[h] * xi;
            float w8[8], w4[4], w2[2], w1_;
            { const bool hi = (p & 32) != 0;
#pragma unroll
              for (int k = 0; k < 8; ++k) { const float send = hi ? v[k] : v[k + 8], keep = hi ? v[k + 8] : v[k]; w8[k] = keep + __shfl_xor(send, 32); } }
            { const bool hi = (p & 16) != 0;
#pragma unroll
              for (int k = 0; k < 4; ++k) { const float send = hi ? w8[k] : w8[k + 4], keep = hi ? w8[k + 4] : w8[k]; w4[k] = keep + __shfl_xor(send, 16); } }
            { const bool hi = (p & 8) != 0;
#pragma unroll
              for (int k = 0; k < 2; ++k) { const float send = hi ? w4[k] : w4[k + 2], keep = hi ? w4[k + 2] : w4[k]; w2[k] = keep + __shfl_xor(send, 8); } }
            { const bool hi = (p & 4) != 0; const float send = hi ? w2[0] : w2[1], keep = hi ? w2[1] : w2[0]; w1_ = keep + __shfl_xor(send, 4); }
            w1_ += __shfl_xor(w1_, 2); w1_ += __shfl_xor(w1_, 1);
            if ((p & 3) == 0) {
                if (d == 0) YT[tok * SSMW + g * GH + hsel] = w1_;
                else { const float uh = __uint_as_float((unsigned)U[tok * SSMW + g * GH + hsel] << 16);
                       const float y = YT[tok * SSMW + g * GH + hsel] + w1_ + dv * uh; Y[tok * SSMW + g * GH + hsel] = (bf16)f2bf(gelu_tanh(y)); } }
        }
        asm volatile("s_waitcnt vmcnt(0)" ::: "memory");
    }
}

__device__ __forceinline__ void p6_final_norm(Frame& F) {
    const int gw = F.vcu * NWAVES + F.wave, NGW = F.G * NWAVES;
    const float* rowss = (const float*)(F.ctl + CW_ROWSS); const float* gf = F.in[22];
    f32x4 g4[4];
#pragma unroll
    for (int j = 0; j < 4; ++j) g4[j] = *(const f32x4*)(gf + 4 * F.lane + 256 * j);
    for (int r = gw; r < M; r += NGW) { const float inv = 1.0f / sqrtf(rowss[r] * (1.f / DM) + EPS);
        GAS f32x4* o = (GAS f32x4*)(F.out + (size_t)r * DM) + F.lane;
#pragma unroll
        for (int j = 0; j < 4; ++j) o[64 * j] = o[64 * j] * inv * g4[j]; }
}
namespace att {
using bf16x8 = __attribute__((ext_vector_type(8))) short;
using s16x4  = __attribute__((ext_vector_type(4))) short;
using f32x16 = __attribute__((ext_vector_type(16))) float;
using u32x4  = __attribute__((ext_vector_type(4))) unsigned;
constexpr int QBLK = 32, KVBLK = 64, LDR = QKVW;
constexpr size_t SHM_V = KVBLK * 128 * 2, SHM_K = KVBLK * 128 * 2, SHM_ATTN = 2 * SHM_V + 2 * SHM_K + NWAVES * 64 * 4;
constexpr float THRL = 8.f * LOG2E;
#define KSWZ(row, colB) ((row) * 256 + ((colB) ^ (((row) & 7) << 4)))
#define SBAR() __builtin_amdgcn_sched_barrier(0)
__device__ __forceinline__ int crow(int r, int hi) { return (r & 3) + 8 * (r >> 2) + 4 * hi; }
__device__ __forceinline__ unsigned cvtpk(float lo, float hi) { unsigned r; asm volatile("v_cvt_pk_bf16_f32 %0, %1, %2" : "=v"(r) : "v"(lo), "v"(hi)); return r; }
__device__ __forceinline__ void partialSM(f32x16& p0, f32x16& p1, float& m_reg, float& mn, float& alpha) {
  float pmax = p0[0];
#pragma unroll
  for (int r = 1; r < 16; ++r) pmax = fmaxf(pmax, p0[r]);
#pragma unroll
  for (int r = 0; r < 16; ++r) pmax = fmaxf(pmax, p1[r]);
  { auto rr = __builtin_amdgcn_permlane32_swap(__float_as_uint(pmax), __float_as_uint(pmax), false, false);
    pmax = fmaxf(__uint_as_float(rr[0]), __uint_as_float(rr[1])); }
  if (__builtin_expect(__all(pmax - m_reg <= THRL), 1)) { mn = m_reg; alpha = 1.f; }
  else { mn = fmaxf(m_reg, pmax); alpha = __builtin_amdgcn_exp2f(m_reg - mn); m_reg = mn; }
#pragma unroll
  for (int r = 0; r < 16; ++r) p0[r] -= mn;
#pragma unroll
  for (int r = 0; r < 16; ++r) p1[r] -= mn;
#pragma unroll
  for (int r = 0; r < 16; ++r) p0[r] = __builtin_amdgcn_exp2f(p0[r]);
}
__device__ __forceinline__ void finishSM(f32x16& p0, f32x16& p1, float alpha, float& l_reg, bf16x8& pa0, bf16x8& pa1, bf16x8& pa2, bf16x8& pa3) {
#pragma unroll
  for (int r = 0; r < 16; ++r) p1[r] = __builtin_amdgcn_exp2f(p1[r]);
  float ps = 0;
#pragma unroll
  for (int r = 0; r < 16; ++r) ps += p0[r];
#pragma unroll
  for (int r = 0; r < 16; ++r) ps += p1[r];
  { auto rr = __builtin_amdgcn_permlane32_swap(__float_as_uint(ps), __float_as_uint(ps), false, false);
    ps = __uint_as_float(rr[0]) + __uint_as_float(rr[1]); }
  l_reg = l_reg * alpha + ps;
#define PK4(P, BASE, OUT) do { unsigned a0 = cvtpk(P[BASE + 0], P[BASE + 1]), a1 = cvtpk(P[BASE + 2], P[BASE + 3]);   \
    unsigned b0 = cvtpk(P[BASE + 4], P[BASE + 5]), b1 = cvtpk(P[BASE + 6], P[BASE + 7]);                              \
    auto r0 = __builtin_amdgcn_permlane32_swap(a0, b0, false, false); auto r1 = __builtin_amdgcn_permlane32_swap(a1, b1, false, false); \
    u32x4 w = {r0[0], r1[0], r0[1], r1[1]}; OUT = *reinterpret_cast<bf16x8*>(&w); } while (0)
  PK4(p0, 0, pa0); PK4(p0, 8, pa1); PK4(p1, 0, pa2); PK4(p1, 8, pa3);
#undef PK4
}
__device__ __forceinline__ void qkt(f32x16& p0, f32x16& p1, const char* Ks, const bf16x8* qr, int r32, int hi, int cofs) {
  p0 = f32x16{}; p1 = f32x16{};
#pragma unroll
  for (int d0 = 0; d0 < 4; ++d0) { const int cb = cofs + (d0 * 16 + hi * 8) * 2;
    const bf16x8 b0 = *reinterpret_cast<const bf16x8*>(Ks + KSWZ(r32, cb));
    const bf16x8 b1 = *reinterpret_cast<const bf16x8*>(Ks + KSWZ(32 + r32, cb));
    p0 = __builtin_amdgcn_mfma_f32_32x32x16_bf16(b0, qr[d0], p0, 0, 0, 0);
    p1 = __builtin_amdgcn_mfma_f32_32x32x16_bf16(b1, qr[d0], p1, 0, 0, 0); }
}
__device__ __forceinline__ int v_st(int k, int c) { const int kk = (k & ~0xC) | ((k & 4) << 1) | ((k & 8) >> 1); return ((kk >> 3) * 4 + (c >> 5)) * 512 + ((kk & 7) * 32 + (c & 31)) * 2; }
__device__ __forceinline__ int v_rd_base(int lane) { return ((lane & 3) << 3) | (((lane >> 2) & 3) << 6) | (((lane >> 4) & 1) << 5) | (((lane >> 5) & 1) << 8); }
constexpr int v_rd_off(int d0, int ks, int half) { return d0 * 512 + ks * 4096 + half * 2048; }
template <int OFF> __device__ __forceinline__ s16x4 tr_read(int vb) {
  s16x4 r; asm volatile("ds_read_b64_tr_b16 %0, %1 offset:%2" : "=&v"(r) : "v"(vb), "i"(OFF) : "memory"); return r;
}
template <int D0> __device__ __forceinline__ void pv_one(f32x16& od, int vb, bf16x8 pa0, bf16x8 pa1, bf16x8 pa2, bf16x8 pa3) {
  const s16x4 l0 = tr_read<v_rd_off(D0, 0, 0)>(vb), h0 = tr_read<v_rd_off(D0, 0, 1)>(vb), l1 = tr_read<v_rd_off(D0, 1, 0)>(vb), h1 = tr_read<v_rd_off(D0, 1, 1)>(vb);
  const s16x4 l2 = tr_read<v_rd_off(D0, 2, 0)>(vb), h2 = tr_read<v_rd_off(D0, 2, 1)>(vb), l3 = tr_read<v_rd_off(D0, 3, 0)>(vb), h3 = tr_read<v_rd_off(D0, 3, 1)>(vb);
  asm volatile("s_waitcnt lgkmcnt(0)" ::: "memory"); SBAR();
#define PK(L, H) (bf16x8){L[0], L[1], L[2], L[3], H[0], H[1], H[2], H[3]}
  od = __builtin_amdgcn_mfma_f32_32x32x16_bf16(pa0, PK(l0, h0), od, 0, 0, 0);
  od = __builtin_amdgcn_mfma_f32_32x32x16_bf16(pa1, PK(l1, h1), od, 0, 0, 0);
  od = __builtin_amdgcn_mfma_f32_32x32x16_bf16(pa2, PK(l2, h2), od, 0, 0, 0);
  od = __builtin_amdgcn_mfma_f32_32x32x16_bf16(pa3, PK(l3, h3), od, 0, 0, 0);
#undef PK
}
__device__ __forceinline__ void pv_d0(f32x16* o, int vb, bf16x8 pa0, bf16x8 pa1, bf16x8 pa2, bf16x8 pa3) {
  pv_one<0>(o[0], vb, pa0, pa1, pa2, pa3); pv_one<1>(o[1], vb, pa0, pa1, pa2, pa3); pv_one<2>(o[2], vb, pa0, pa1, pa2, pa3); pv_one<3>(o[3], vb, pa0, pa1, pa2, pa3);
}
__device__ __forceinline__ void attn_unit(int b, int h, int qb, const unsigned short* __restrict__ QKVb, const unsigned short* __restrict__ ZA, unsigned short* __restrict__ AIN,
                                          const float* __restrict__ gsub, float lam, char* lds) {
  const int tid = threadIdx.x, wid = tid >> 6, lane = tid & 63, r32 = lane & 31, hi = lane >> 5, c = wid >> 2, wq = wid & 3;
  char* V_lds = lds; char* K_lds = lds + 2 * SHM_V;
  float* ws = (float*)(lds + 2 * SHM_V + 2 * SHM_K) + wid * 64; float* li_l = ws; float* al_l = ws + 32;
  float m_reg = -1e30f, l_reg = 0; f32x16 o[4] = {}; bf16x8 qr[4];
  const long tok0 = (long)b * SEQ + qb * 128;
  const unsigned short* Qw = QKVb + (tok0 + wq * QBLK + r32) * LDR + h * 128 + c * 64 + hi * 8;
#pragma unroll
  for (int d0 = 0; d0 < 4; ++d0) qr[d0] = *reinterpret_cast<const bf16x8*>(Qw + d0 * 16);
  const unsigned short* Kh = QKVb + (long)b * SEQ * LDR + 512 + h * 128; const unsigned short* Vh = Kh + 512;
  const int cofs = c * 128;
  const int sr = tid >> 4, sc = (tid & 15) * 8, vst0 = v_st(sr, sc), vst1 = v_st(32 + sr, sc);
  const int vb0 = (int)(uintptr_t)V_lds + v_rd_base(lane);
  struct { bf16x8 vs0, vs1, ks0, ks1; } sr_[2];
#define SLOAD(i, k0) do { sr_[i].vs0 = *reinterpret_cast<const bf16x8*>(&Vh[(long)((k0) + sr) * LDR + sc]); sr_[i].vs1 = *reinterpret_cast<const bf16x8*>(&Vh[(long)((k0) + 32 + sr) * LDR + sc]); \
    sr_[i].ks0 = *reinterpret_cast<const bf16x8*>(&Kh[(long)((k0) + sr) * LDR + sc]); sr_[i].ks1 = *reinterpret_cast<const bf16x8*>(&Kh[(long)((k0) + 32 + sr) * LDR + sc]); } while (0)
#define SWRITE(bb, i) do { *(bf16x8*)(V_lds + (bb) * SHM_V + vst0) = sr_[i].vs0;          \
    *(bf16x8*)(V_lds + (bb) * SHM_V + vst1) = sr_[i].vs1; const int kc = sc * 2;               \
    *(bf16x8*)(K_lds + (bb) * SHM_K + KSWZ(sr, kc)) = sr_[i].ks0;                       \
    *(bf16x8*)(K_lds + (bb) * SHM_K + KSWZ(32 + sr, kc)) = sr_[i].ks1; } while (0)
#define SWAIT() asm volatile("s_waitcnt vmcnt(4)" ::: "memory")
#define RESC(a) do { if (__any((a) < 1.f)) { if (hi == 0) al_l[r32] = (a); asm volatile("s_waitcnt lgkmcnt(0)" ::: "memory"); \
    _Pragma("unroll") for (int d = 0; d < 4; ++d) _Pragma("unroll") for (int r = 0; r < 16; ++r) o[d][r] *= al_l[crow(r, hi)]; } } while (0)
  f32x16 pA0, pA1, pB0, pB1; float mnA, mnB, alA, alB; bf16x8 pa0, pa1, pa2, pa3; constexpr int NT = SEQ / KVBLK;
  constexpr int SE = 0, SO = 1;
  SLOAD(SE, 0); asm volatile("s_waitcnt vmcnt(0)" ::: "memory"); SWRITE(0, SE); __syncthreads();
  qkt(pA0, pA1, K_lds, qr, r32, hi, cofs); partialSM(pA0, pA1, m_reg, mnA, alA);
  SLOAD(SO, KVBLK); SLOAD(SE, 2 * KVBLK);
  SWAIT(); SWRITE(1, SO); __syncthreads();
  for (int j = 1; j + 1 < NT; j += 2) {
    SBAR(); qkt(pB0, pB1, K_lds + SHM_K, qr, r32, hi, cofs);
    finishSM(pA0, pA1, alA, l_reg, pa0, pa1, pa2, pa3); SBAR();
    SLOAD(SO, (j + 2) * KVBLK); SBAR();
    pv_d0(o, vb0, pa0, pa1, pa2, pa3); partialSM(pB0, pB1, m_reg, mnB, alB);
    __syncthreads(); SWAIT(); SWRITE(0, SE);
    RESC(alB); __syncthreads();
    SBAR(); qkt(pA0, pA1, K_lds, qr, r32, hi, cofs);
    finishSM(pB0, pB1, alB, l_reg, pa0, pa1, pa2, pa3); SBAR();
    if (j + 3 < NT) SLOAD(SE, (j + 3) * KVBLK); SBAR();
    pv_d0(o, vb0 + (int)SHM_V, pa0, pa1, pa2, pa3); partialSM(pA0, pA1, m_reg, mnA, alA);
    __syncthreads(); SWAIT(); SWRITE(1, SO);
    RESC(alA); __syncthreads();
  }
  SBAR(); qkt(pB0, pB1, K_lds + SHM_K, qr, r32, hi, cofs);
  finishSM(pA0, pA1, alA, l_reg, pa0, pa1, pa2, pa3); SBAR();
  pv_d0(o, vb0, pa0, pa1, pa2, pa3); partialSM(pB0, pB1, m_reg, mnB, alB);
  __syncthreads(); RESC(alB);
  finishSM(pB0, pB1, alB, l_reg, pa0, pa1, pa2, pa3); SBAR();
  pv_d0(o, vb0 + (int)SHM_V, pa0, pa1, pa2, pa3);
  if (hi == 0) li_l[r32] = l_reg; asm volatile("s_waitcnt lgkmcnt(0)" ::: "memory");
  float rli[16];
#pragma unroll
  for (int r = 0; r < 16; ++r) rli[r] = __builtin_amdgcn_rcpf(li_l[crow(r, hi)]);
  float* X = (float*)lds + wq * (64 * 64);
  __syncthreads();
  if (c == 1) {
#pragma unroll
    for (int r = 0; r < 16; ++r)
#pragma unroll
      for (int d0 = 0; d0 < 4; ++d0) X[(r * 4 + d0) * 64 + lane] = o[d0][r] * rli[r];
  }
  __syncthreads();
  if (c == 0) {
#pragma unroll
    for (int r = 0; r < 16; ++r)
#pragma unroll
      for (int d0 = 0; d0 < 4; ++d0) o[d0][r] = o[d0][r] * rli[r] - lam * X[(r * 4 + d0) * 64 + lane];
  }
  __syncthreads();
  if (c == 0) {
    float gs[4];
#pragma unroll
    for (int d0 = 0; d0 < 4; ++d0) gs[d0] = gsub[d0 * 32 + r32] * (1.0f - LAM_INIT);
#pragma unroll
    for (int r = 0; r < 16; ++r) {
      float ss = (o[0][r] * o[0][r] + o[1][r] * o[1][r]) + (o[2][r] * o[2][r] + o[3][r] * o[3][r]);
#pragma unroll
      for (int off = 1; off < 32; off <<= 1) ss += __shfl_xor(ss, off);
      const float inv = 1.0f / sqrtf(ss * (1.0f / 128.0f) + EPS);
      const long tok = tok0 + wq * QBLK + crow(r, hi); const unsigned short* zp = ZA + tok * 512 + h * 128 + r32; unsigned short* op = AIN + tok * 512 + h * 128 + r32;
#pragma unroll
      for (int d0 = 0; d0 < 4; ++d0) { const float z = __uint_as_float((unsigned)zp[d0 * 32] << 16); op[d0 * 32] = (unsigned short)f2bf(o[d0][r] * inv * gs[d0] * z); }
    }
  }
#undef SLOAD
#undef SWRITE
#undef SWAIT
#undef RESC
}
#undef KSWZ
#undef SBAR
}
#ifndef MK_N_LAUNCHES
#define MK_N_LAUNCHES 1
#endif
constexpr int N_PHASES = 9;
struct Args { const float* in[23]; float* out; unsigned char* ws; int ph_lo, ph_hi; };
__global__ void __launch_bounds__(NWAVES * 64, 2) fwd_kernel(Args args) {
    extern __shared__ __attribute__((aligned(16))) unsigned char lds[];
    Frame F;
    F.lds = (LAS unsigned char*)lds;
    F.MISC = (volatile LAS unsigned*)(F.lds + MISC_OFF);
    F.tid = threadIdx.x; F.lane = F.tid & 63; F.wave = __builtin_amdgcn_readfirstlane(F.tid >> 6);
    F.G = gridDim.x; { const int bx = blockIdx.x; F.vcu = (F.G % 8 == 0) ? (bx % 8) * (F.G / 8) + bx / 8 : bx; }
    F.ws = args.ws; F.out = args.out; F.ctl = (gu32*)(args.ws + WS_CTL);
#pragma unroll
    for (int i = 0; i < 23; ++i) F.in[i] = args.in[i];
    for (int u = F.tid; u < (LDS_BYTES - LDSCTL_OFF) / 4; u += NWAVES * 64) ((LAS unsigned*)(F.lds + LDSCTL_OFF))[u] = 0u;
    __syncthreads();
    const int lo = args.ph_lo, hi = args.ph_hi;
    const bool multi = (hi - lo) > 1;
    XcdBarrier bar; bar.bar = (unsigned*)(F.ctl + CW_BAR); bar.x = 0; bar.st = nullptr;
    if (multi) bar = xcd_barrier_post((unsigned*)(F.ctl + CW_BAR), F.MISC + 8);
#define IN(k) (lo <= (k) && (k) < hi)
#define SEAM(k) do { if (IN(k) && IN((k) + 1)) xcd_barrier(bar); } while (0)
    bf16* ws16 = (bf16*)args.ws;
    if (IN(0)) { p0_prologue(F); SEAM(0); }
    if (IN(1)) { p1a_norm(F); SEAM(1); }
    if (IN(2)) {
        pg8::Gemm g{ws16 + WS_H / 2, ws16 + WS_WIN / 2, M, NPROJ, DM}; pg8::StaticOrder S; S.init(M, NPROJ, F.G, (int)blockIdx.x);
        pg8::EpiProj E{ws16 + WS_QKV / 2, ws16 + WS_ZA / 2, ws16 + WS_U / 2, ws16 + WS_ZS / 2, ws16 + WS_GA / 2, ws16 + WS_GS / 2, (const float*)(args.ws + WS_ROPE), QSCALE};
        pg8::gemm_phase<pg8::EpiProj, pg8::StaticOrder, true, true>(F.lds + RING_OFF, g, S, E);
        SEAM(2); }
    if (IN(3)) {
#ifdef NAIVE_ATTN
        for (int u = F.vcu; u < NB * NH * 32; u += F.G) attn_naive_unit(F, u);
#else
        { float lam; { const float* lq = F.in[7]; float d1 = 0.f, d2 = 0.f; for (int i = 0; i < 64; ++i) { d1 += lq[i] * lq[64 + i]; d2 += lq[128 + i] * lq[192 + i]; } lam = __expf(d1) - __expf(d2) + LAM_INIT; }
          for (int u = F.vcu; u < NB * NH * 16; u += F.G) { const int bh = u >> 4, qb = u & 15;
              att::attn_unit(bh >> 2, bh & 3, qb, ws16 + WS_QKV / 2, ws16 + WS_ZA / 2, ws16 + WS_AIN / 2, F.in[8], lam, (char*)lds + RING_OFF); } }
#endif
        { const int gw = F.vcu * NWAVES + F.wave; if ((gw & 3) == 0 && (gw >> 2) < NB * NG) ssm_naive_unit(F, gw >> 2); }
        SEAM(3); }
    if (IN(4)) {
        pg8::Gemm g{ws16 + WS_Y / 2, ws16 + WS_WGLU / 2, M, 512, 512}; pg8::StaticOrder S; S.init(M, 512, F.G, (int)blockIdx.x);
        pg8::EpiGlu E{ws16 + WS_Y / 2, ws16 + WS_ZS / 2, ws16 + WS_Y2 / 2, F.in[18]};
        pg8::gemm_phase<pg8::EpiGlu, pg8::StaticOrder, true, true>(F.lds + RING_OFF, g, S, E);
        SEAM(4); }
    if (IN(5)) {
        pg8::Gemm g{ws16 + WS_AIN / 2, ws16 + WS_WUPA / 2, M, DM, 512}; pg8::StaticOrder S; S.init(M, DM, F.G, (int)blockIdx.x);
        pg8::EpiMerge<0> E{ws16 + WS_GA / 2, nullptr};
        pg8::gemm_phase<pg8::EpiMerge<0>, pg8::StaticOrder, true, true>(F.lds + RING_OFF, g, S, E);
        SEAM(5); }
    if (IN(6)) {
        pg8::Gemm g{ws16 + WS_Y2 / 2, ws16 + WS_WUPS / 2, M, DM, 512}; pg8::StaticOrder S; S.init(M, DM, F.G, (int)blockIdx.x);
        pg8::EpiMerge<1> E{ws16 + WS_GA / 2, ws16 + WS_GS / 2};
        pg8::gemm_phase<pg8::EpiMerge<1>, pg8::StaticOrder, true, true>(F.lds + RING_OFF, g, S, E);
        SEAM(6); }
    if (IN(7)) {
        pg8::Gemm g{ws16 + WS_GA / 2, ws16 + WS_WOUT / 2, M, DM, DM}; pg8::StaticOrder S; S.init(M, DM, F.G, (int)blockIdx.x);
        pg8::EpiOut E{F.in[0], (const float*)(args.ws + WS_GATE), F.out, (float*)(F.ctl + CW_ROWSS)};
        pg8::gemm_phase<pg8::EpiOut, pg8::StaticOrder, true, true>(F.lds + RING_OFF, g, S, E);
        SEAM(7); }
    if (IN(8)) { p6_final_norm(F); }
#undef IN
#undef SEAM
}

extern "C" void kernel_launch(void* const* d_in, const int* in_sizes, int n_in, void* d_out, int out_size, void* d_ws, size_t ws_size, hipStream_t stream) {
    static int grid = 0;
    if (grid == 0) {
        if (n_in != 23 || in_sizes[0] != M * DM || out_size != M * DM || ws_size < WS_END) { fprintf(stderr, "kernel_launch: shape/workspace mismatch (n_in %d, in0 %d, out %d, ws %zu)\n", n_in, n_in > 0 ? in_sizes[0] : -1, out_size, ws_size); grid = -1; return; }
        if (hipFuncSetAttribute((const void*)fwd_kernel, hipFuncAttributeMaxDynamicSharedMemorySize, LDS_BYTES) != hipSuccess) { fprintf(stderr, "kernel_launch: hipFuncSetAttribute failed\n"); grid = -1; return; }
        int per_cu = 0;
        if (hipOccupancyMaxActiveBlocksPerMultiprocessor(&per_cu, (const void*)fwd_kernel, NWAVES * 64, LDS_BYTES) != hipSuccess || per_cu < 1) fprintf(stderr, "kernel_launch: occupancy query reports %d\n", per_cu);
        (void)hipGetLastError();
        grid = 256;
    }
    if (grid < 0) return;
    if (hipMemsetAsync((char*)d_ws + WS_CTL, 0, CTL_ZERO_BYTES, stream) != hipSuccess) { fprintf(stderr, "kernel_launch: memset failed\n"); return; }
    Args a{};
    for (int i = 0; i < 23; ++i) a.in[i] = (const float*)d_in[i];
    a.out = (float*)d_out; a.ws = (unsigned char*)d_ws;
    if (MK_N_LAUNCHES == 1) { a.ph_lo = 0; a.ph_hi = N_PHASES; hipLaunchKernelGGL(fwd_kernel, dim3(grid), dim3(NWAVES * 64), LDS_BYTES, stream, a); }
    else for (int p = 0; p < N_PHASES; ++p) { a.ph_lo = p; a.ph_hi = p + 1; hipLaunchKernelGGL(fwd_kernel, dim3(grid), dim3(NWAVES * 64), LDS_BYTES, stream, a); }
    const hipError_t le = hipPeekAtLastError();
    if (le != hipSuccess) fprintf(stderr, "kernel_launch: launch failed: %s\n", hipGetErrorName(le));
}
```

```cpp
#include <hip/hip_runtime.h>
#include <cstdio>
#include <cstdint>
namespace pg8 {
#define PG8_LAS __attribute__((address_space(3)))
typedef unsigned short bf16_t;
typedef short bf16x8 __attribute__((ext_vector_type(8)));
typedef float f32x4 __attribute__((ext_vector_type(4)));
typedef unsigned u32x4 __attribute__((ext_vector_type(4)));
constexpr int BM = 256, BK = 64, HALF = 128, HTB = HALF * BK * 2  , STAGE_BYTES = 8 * HTB, NXCD = 8, WGM = 8;

__host__ __device__ __forceinline__ int lds_byte(int r, int c) { const int st = (r >> 4) * 2 + (c >> 5), rr = r & 15, cc = c & 31, ob = rr * 64 + cc * 2; return st * 1024 + (ob ^ (((ob >> 9) & 1) << 5)); }
__host__ __device__ __forceinline__ void stage_rc(int b, int& R, int& C) { const int st = b / 1024, sb = b % 1024, swz = sb ^ (((sb >> 9) & 1) << 5); R = (st >> 1) * 16 + swz / 64; C = (st & 1) * 32 + (swz % 64) / 2; }
__host__ __device__ __forceinline__ int perm32(int rho) { const int n = rho >> 4, i = rho & 15; return 8 * (i >> 2) + 4 * n + (i & 3); }

struct Unit { int pm, pn; };
struct Gemm { const bf16_t* A; const bf16_t* Bt; int M, N, K; };

struct StaticOrder {
    int nM, nN, nwg, G, c;
    __host__ __device__ void init(int M, int N, int G_, int c_) { nM = M / BM; nN = N / BM; nwg = nM * nN; G = G_; c = c_; }
    __host__ __device__ bool next(int i, Unit& u) const {
        const long L = (long)i * G + c; if (L >= nwg) return false;
        int wgid = (int)L; { const int q = nwg / NXCD, r = nwg % NXCD, xcd = wgid % NXCD, off = wgid / NXCD; wgid = (xcd < r ? xcd * (q + 1) : r * (q + 1) + (xcd - r) * q) + off; }
        const int nig = WGM * nN, gid = wgid / nig, fm = gid * WGM, gsz = (nM - fm) < WGM ? (nM - fm) : WGM;
        u.pm = fm + ((wgid % nig) % gsz); u.pn = (wgid % nig) / gsz; return true;
    }
    __device__ __forceinline__ void a_ready(const Unit&) const {}
    __device__ __forceinline__ void done(const Unit&) const {}
};

__device__ __forceinline__ unsigned cvt_pk_bf16(float lo, float hi) { unsigned r; asm volatile("v_cvt_pk_bf16_f32 %0, %1, %2" : "=v"(r) : "v"(lo), "v"(hi)); return r; }
__device__ __forceinline__ float bf_lo(unsigned w) { return __uint_as_float(w << 16); }
__device__ __forceinline__ float bf_hi(unsigned w) { return __uint_as_float(w & 0xffff0000u); }
__device__ __forceinline__ float sigmoid_f(float x) { return __builtin_amdgcn_rcpf(1.0f + __builtin_amdgcn_exp2f(-1.4426950408889634f * x)); }
__device__ __forceinline__ void unpack8(const u32x4 w, float (&f)[8]) { f[0] = bf_lo(w.x); f[1] = bf_hi(w.x); f[2] = bf_lo(w.y); f[3] = bf_hi(w.y); f[4] = bf_lo(w.z); f[5] = bf_hi(w.z); f[6] = bf_lo(w.w); f[7] = bf_hi(w.w); }
__device__ __forceinline__ u32x4 pack8(const float (&f)[8]) { u32x4 w; w.x = cvt_pk_bf16(f[0], f[1]); w.y = cvt_pk_bf16(f[2], f[3]); w.z = cvt_pk_bf16(f[4], f[5]); w.w = cvt_pk_bf16(f[6], f[7]); return w; }

struct EpiProj {
    static constexpr bool PERM = true, AFTER_DRAIN = false;
    bf16_t *QKV, *ZA, *U, *ZS, *GA, *GS; const float* rope; float qscale;
    __device__ __forceinline__ void operator()(const f32x4 (&acc)[2][2][4][2], const Unit& u, int wr, int wc, int fr, int fq) const {
        const int pn = u.pn; bf16_t* base; int ldc, colt, act;
        float sc = 1.f;
        if (pn < 2)       { base = QKV; ldc = 1536; colt = pn * 256; act = 3; sc = qscale; }
        else if (pn < 4)  { base = QKV; ldc = 1536; colt = 512 + (pn - 2) * 256; act = 3; }
        else if (pn < 6)  { base = QKV; ldc = 1536; colt = 1024 + (pn - 4) * 256; act = 0; }
        else if (pn < 8)  { base = ZA; ldc = 512; colt = (pn - 6) * 256; act = 1; }
        else if (pn < 10) { base = U;  ldc = 512; colt = (pn - 8) * 256; act = 0; }
        else if (pn < 12) { base = ZS; ldc = 512; colt = (pn - 10) * 256; act = 1; }
        else if (pn < 16) { base = GA; ldc = 1024; colt = (pn - 12) * 256; act = 2; }
        else              { base = GS; ldc = 1024; colt = (pn - 16) * 256; act = 2; }
        const int row0 = u.pm * BM + wr * 64 + fr, col0 = colt + wc * 32 + 8 * fq;
        const bool rotw = (act == 3) && ((wc & 1) == 0);
#pragma unroll
        for (int ai = 0; ai < 2; ++ai)
#pragma unroll
            for (int m = 0; m < 4; ++m) {
                const int row = row0 + ai * HALF + m * 16; bf16_t* rowp = base + (size_t)row * ldc + col0;
                float cs[8], sn[8];
                if (rotw) { const f32x4* rp = (const f32x4*)(rope + (size_t)row * 16); const f32x4 c0 = rp[0], c1 = rp[1], s0 = rp[2], s1 = rp[3];
                    cs[0] = c0[0]; cs[1] = c0[1]; cs[2] = c0[2]; cs[3] = c0[3]; cs[4] = c1[0]; cs[5] = c1[1]; cs[6] = c1[2]; cs[7] = c1[3];
                    sn[0] = s0[0]; sn[1] = s0[1]; sn[2] = s0[2]; sn[3] = s0[3]; sn[4] = s1[0]; sn[5] = s1[1]; sn[6] = s1[2]; sn[7] = s1[3]; }
#pragma unroll
                for (int bj = 0; bj < 2; ++bj) {
                    float v[8];
#pragma unroll
                    for (int e = 0; e < 4; ++e) { v[e] = acc[ai][bj][m][0][e]; v[4 + e] = acc[ai][bj][m][1][e]; }
                    if (act == 1) {
#pragma unroll
                        for (int e = 0; e < 8; ++e) v[e] = v[e] * sigmoid_f(v[e]);
                    } else if (act == 2) {
#pragma unroll
                        for (int e = 0; e < 8; ++e) v[e] = sigmoid_f(v[e]);
                    } else if (act == 3) {
                        if (rotw) {
#pragma unroll
                            for (int e = 0; e < 8; ++e) { const float o = __shfl_xor(v[e], 16);
                                const float r1 = v[e] * cs[e] - o * sn[e], r2 = v[e] * cs[e] + o * sn[e];
                                v[e] = (fq == 0) ? r1 : ((fq == 1) ? r2 : v[e]); }
                        }
#pragma unroll
                        for (int e = 0; e < 8; ++e) v[e] *= sc;
                    }
                    *(u32x4*)(rowp + bj * HALF) = pack8(v);
                }
            }
    }
};
struct EpiGlu {
    static constexpr bool PERM = true, AFTER_DRAIN = false;
    const bf16_t *Y, *ZS; bf16_t* Y2; const float* bias;
    __device__ __forceinline__ void operator()(const f32x4 (&acc)[2][2][4][2], const Unit& u, int wr, int wc, int fr, int fq) const {
        const int row0 = u.pm * BM + wr * 64 + fr, col0 = u.pn * BM + wc * 32 + 8 * fq;
#pragma unroll
        for (int ai = 0; ai < 2; ++ai)
#pragma unroll
            for (int m = 0; m < 4; ++m) { const size_t off = (size_t)(row0 + ai * HALF + m * 16) * 512 + col0;
#pragma unroll
                for (int bj = 0; bj < 2; ++bj) {
                    const f32x4 b0 = *(const f32x4*)(bias + col0 + bj * HALF), b1 = *(const f32x4*)(bias + col0 + bj * HALF + 4);
                    float yv[8], zv[8], v[8]; unpack8(*(const u32x4*)(Y + off + bj * HALF), yv); unpack8(*(const u32x4*)(ZS + off + bj * HALF), zv);
#pragma unroll
                    for (int e = 0; e < 4; ++e) { v[e] = yv[e] * sigmoid_f(acc[ai][bj][m][0][e] + b0[e]) * zv[e]; v[4 + e] = yv[4 + e] * sigmoid_f(acc[ai][bj][m][1][e] + b1[e]) * zv[4 + e]; }
                    *(u32x4*)(Y2 + off + bj * HALF) = pack8(v);
                } }
    }
};
template <int MODE> struct EpiMerge {
    static constexpr bool PERM = true, AFTER_DRAIN = false;
    bf16_t* G; const bf16_t* G2;
    __device__ __forceinline__ void operator()(const f32x4 (&acc)[2][2][4][2], const Unit& u, int wr, int wc, int fr, int fq) const {
        const int row0 = u.pm * BM + wr * 64 + fr, col0 = u.pn * BM + wc * 32 + 8 * fq;
#pragma unroll
        for (int ai = 0; ai < 2; ++ai)
#pragma unroll
            for (int m = 0; m < 4; ++m) { const size_t off = (size_t)(row0 + ai * HALF + m * 16) * 1024 + col0;
#pragma unroll
                for (int bj = 0; bj < 2; ++bj) {
                    float g[8], v[8]; unpack8(*(const u32x4*)(G + off + bj * HALF), g);
                    if (MODE == 0) {
#pragma unroll
                        for (int e = 0; e < 4; ++e) { v[e] = g[e] * acc[ai][bj][m][0][e]; v[4 + e] = g[4 + e] * acc[ai][bj][m][1][e]; }
                    } else { float g2[8]; unpack8(*(const u32x4*)(G2 + off + bj * HALF), g2);
#pragma unroll
                        for (int e = 0; e < 4; ++e) { v[e] = g[e] + g2[e] * acc[ai][bj][m][0][e]; v[4 + e] = g[4 + e] + g2[4 + e] * acc[ai][bj][m][1][e]; }
                    }
                    *(u32x4*)(G + off + bj * HALF) = pack8(v);
                } }
    }
};
struct EpiOut {
    static constexpr bool PERM = true, AFTER_DRAIN = false;
    const float* x; const float* gate; float* out; float* rowss;
    __device__ __forceinline__ void operator()(const f32x4 (&acc)[2][2][4][2], const Unit& u, int wr, int wc, int fr, int fq) const {
        const int row0 = u.pm * BM + wr * 64 + fr, col0 = u.pn * BM + wc * 32 + 8 * fq;
        const float* gb = gate + (size_t)((u.pm * BM) >> 11) * 1024;
        f32x4 g[2][2];
#pragma unroll
        for (int bj = 0; bj < 2; ++bj) { g[bj][0] = *(const f32x4*)(gb + col0 + bj * HALF); g[bj][1] = *(const f32x4*)(gb + col0 + bj * HALF + 4); }
#pragma unroll
        for (int ai = 0; ai < 2; ++ai)
#pragma unroll
            for (int m = 0; m < 4; ++m) { const int row = row0 + ai * HALF + m * 16; const size_t off = (size_t)row * 1024 + col0; float ss = 0.f;
#pragma unroll
                for (int bj = 0; bj < 2; ++bj)
#pragma unroll
                    for (int n = 0; n < 2; ++n) { const f32x4 xv = *(const f32x4*)(x + off + bj * HALF + 4 * n); const f32x4 o = xv + g[bj][n] * acc[ai][bj][m][n];
                        *(f32x4*)(out + off + bj * HALF + 4 * n) = o; ss += (o[0] * o[0] + o[1] * o[1]) + (o[2] * o[2] + o[3] * o[3]); }
                ss += __shfl_xor(ss, 16); ss += __shfl_xor(ss, 32);
                if (fq == 0) atomicAdd(rowss + row, ss); }
    }
};

template <class Epi, class Sched, bool ALIGN_EPI = false, bool SP2 = false>
__device__ __forceinline__ void gemm_phase(PG8_LAS unsigned char* lds, const Gemm g, const Sched& S, const Epi& E) {
    const int tid = threadIdx.x, wid = __builtin_amdgcn_readfirstlane(tid >> 6), lane = tid & 63, wr = wid >> 2, wc = wid & 3, fr = lane & 15, fq = lane >> 4;
    const int K = g.K, nt = K / BK;
    unsigned voffA[2], voffB[2];
#pragma unroll
    for (int i = 0; i < 2; ++i) { int R, C; stage_rc(tid * 16 + i * 8192, R, C); const int Rb = Epi::PERM ? ((R & ~31) + perm32(R & 31)) : R;
        voffA[i] = (unsigned)(R * K + C) * 2u; voffB[i] = (unsigned)(Rb * K + C) * 2u; }
    const size_t kstep = (size_t)(BK * 2);
    const size_t hstep = (size_t)HALF * K * 2;
    const size_t tstep = 2 * hstep;
    const unsigned ldsw = (unsigned)wid * 1024u;
    const int aoff = lds_byte(wr * 64 + fr, fq * 8), boff = lds_byte(wc * 32 + fr, fq * 8);
#define PG8_SA(b, h) (((b) * 2 + (h)) * HTB)
#define PG8_SB(b, h) ((4 + (b) * 2 + (h)) * HTB)
#define PG8_STAGE(bufoff, gbase, voff) do { _Pragma("unroll") for (int _i = 0; _i < 2; ++_i) \
        __builtin_amdgcn_global_load_lds((const unsigned*)((const char*)(gbase) + (voff)[_i]), (PG8_LAS unsigned*)(lds + (bufoff) + ldsw + _i * 8192), 16, 0, 0); } while (0)
#define PG8_LDA(dst, b, h) do { _Pragma("unroll") for (int m = 0; m < 4; ++m) _Pragma("unroll") for (int k = 0; k < 2; ++k) dst[m][k] = *(const PG8_LAS bf16x8*)(lds + PG8_SA(b, h) + aoff + m * 2048 + k * 1024); } while (0)
#define PG8_LDB(dst, b, h) do { _Pragma("unroll") for (int n = 0; n < 2; ++n) _Pragma("unroll") for (int k = 0; k < 2; ++k) dst[n][k] = *(const PG8_LAS bf16x8*)(lds + PG8_SB(b, h) + boff + n * 2048 + k * 1024); } while (0)
#define PG8_MMA(ai, bj, At, Bt) do { __builtin_amdgcn_s_setprio(1); _Pragma("unroll") for (int m = 0; m < 4; ++m) _Pragma("unroll") for (int n = 0; n < 2; ++n) _Pragma("unroll") for (int k = 0; k < 2; ++k) \
        acc[ai][bj][m][n] = __builtin_amdgcn_mfma_f32_16x16x32_bf16(Bt[n][k], At[m][k], acc[ai][bj][m][n], 0, 0, 0); __builtin_amdgcn_s_setprio(0); } while (0)
#define PG8_WAIT_V(n) asm volatile("s_waitcnt vmcnt(" #n ")" ::: "memory")
#define PG8_WAIT_L(n) asm volatile("s_waitcnt lgkmcnt(" #n ")" ::: "memory")
#define PG8_BAR __builtin_amdgcn_s_barrier()
#define PG8_SCHED __builtin_amdgcn_sched_barrier(0)
    Unit cur, nxt; int ui = 0;
    if (!S.next(0, cur)) return;
    f32x4 acc[2][2][4][2];
#pragma unroll
    for (int a = 0; a < 2; ++a)
#pragma unroll
        for (int b = 0; b < 2; ++b)
#pragma unroll
            for (int m = 0; m < 4; ++m)
#pragma unroll
                for (int n = 0; n < 2; ++n) acc[a][b][m][n] = (f32x4){0.f, 0.f, 0.f, 0.f};
    bf16x8 At[4][2], B0[2][2], B1[2][2];
    const char* cA = (const char*)g.A + (size_t)cur.pm * tstep; const char* cB = (const char*)g.Bt + (size_t)cur.pn * tstep;
    S.a_ready(cur);
    if constexpr (SP2) {
        PG8_STAGE(PG8_SB(0, 0), cB, voffB); PG8_STAGE(PG8_SB(0, 1), cB + hstep, voffB); PG8_STAGE(PG8_SA(0, 0), cA, voffA); PG8_STAGE(PG8_SA(0, 1), cA + hstep, voffA);
        if (wr == 1) PG8_BAR;
        PG8_WAIT_V(2); PG8_BAR;
        PG8_STAGE(PG8_SB(1, 0), cB + kstep, voffB); PG8_STAGE(PG8_SA(1, 0), cA + kstep, voffA); PG8_STAGE(PG8_SB(1, 1), cB + hstep + kstep, voffB);
        PG8_WAIT_V(6); PG8_BAR;
    } else {
        PG8_STAGE(PG8_SB(0, 0), cB, voffB); PG8_STAGE(PG8_SA(0, 0), cA, voffA); PG8_STAGE(PG8_SB(0, 1), cB + hstep, voffB); PG8_STAGE(PG8_SA(0, 1), cA + hstep, voffA);
        if (wr == 1) PG8_BAR;
        PG8_WAIT_V(4); PG8_BAR;
        PG8_STAGE(PG8_SB(1, 0), cB + kstep, voffB); PG8_STAGE(PG8_SA(1, 0), cA + kstep, voffA); PG8_STAGE(PG8_SB(1, 1), cB + hstep + kstep, voffB);
        PG8_WAIT_V(6); PG8_BAR;
    }
    for (;;) {
        const bool has_next = S.next(ui + 1, nxt);
        const char* nA = has_next ? (const char*)g.A + (size_t)nxt.pm * tstep : cA; const char* nB = has_next ? (const char*)g.Bt + (size_t)nxt.pn * tstep : cB;
        for (int t = 0; t < nt; t += 2) {
            const bool last = (t == nt - 2);
            const char* a1 = cA + (size_t)(t + 1) * kstep;
            const char* a2 = last ? nA : cA + (size_t)(t + 2) * kstep; const char* b2 = last ? nB : cB + (size_t)(t + 2) * kstep;
            const char* a3 = a2 + kstep; const char* b3 = b2 + kstep;
            if (last && has_next) S.a_ready(nxt);
            if constexpr (SP2) {
            PG8_LDB(B0, 0, 0); PG8_LDB(B1, 0, 1); PG8_SCHED; PG8_LDA(At, 0, 0); PG8_STAGE(PG8_SA(1, 1), a1 + hstep, voffA);
            PG8_WAIT_V(8); PG8_WAIT_L(0); PG8_BAR; PG8_MMA(0, 0, At, B0); PG8_MMA(0, 1, At, B1); PG8_BAR; PG8_SCHED;
            PG8_LDA(At, 0, 1); PG8_STAGE(PG8_SB(0, 0), b2, voffB); PG8_STAGE(PG8_SB(0, 1), b2 + hstep, voffB); PG8_STAGE(PG8_SA(0, 0), a2, voffA);
            PG8_WAIT_V(8); PG8_WAIT_L(0); PG8_BAR; PG8_MMA(1, 0, At, B0); PG8_MMA(1, 1, At, B1); PG8_BAR; PG8_SCHED;
            PG8_LDB(B0, 1, 0); PG8_LDB(B1, 1, 1); PG8_SCHED; PG8_LDA(At, 1, 0); PG8_STAGE(PG8_SA(0, 1), a2 + hstep, voffA);
            PG8_WAIT_V(8); PG8_WAIT_L(0); PG8_BAR; PG8_MMA(0, 0, At, B0); PG8_MMA(0, 1, At, B1); PG8_BAR; PG8_SCHED;
            PG8_LDA(At, 1, 1); PG8_STAGE(PG8_SB(1, 0), b3, voffB); PG8_STAGE(PG8_SB(1, 1), b3 + hstep, voffB); PG8_STAGE(PG8_SA(1, 0), a3, voffA);
            PG8_WAIT_V(8); PG8_WAIT_L(0); PG8_BAR; PG8_MMA(1, 0, At, B0); PG8_MMA(1, 1, At, B1); PG8_BAR; PG8_SCHED;
            } else {
            PG8_LDB(B0, 0, 0); PG8_SCHED; PG8_LDA(At, 0, 0); PG8_STAGE(PG8_SA(1, 1), a1 + hstep, voffA);
            PG8_WAIT_L(8); PG8_BAR; PG8_WAIT_L(0); PG8_MMA(0, 0, At, B0); PG8_BAR; PG8_SCHED;
            PG8_LDB(B1, 0, 1); PG8_STAGE(PG8_SB(0, 0), b2, voffB);
            PG8_BAR; PG8_WAIT_L(0); PG8_MMA(0, 1, At, B1); PG8_BAR;
            PG8_LDA(At, 0, 1); PG8_STAGE(PG8_SA(0, 0), a2, voffA);
            PG8_BAR; PG8_WAIT_L(0); PG8_MMA(1, 0, At, B0); PG8_BAR; PG8_SCHED;
            PG8_STAGE(PG8_SB(0, 1), b2 + hstep, voffB);
            PG8_WAIT_V(6); PG8_BAR; PG8_MMA(1, 1, At, B1); PG8_BAR;
            PG8_LDB(B0, 1, 0); PG8_SCHED; PG8_LDA(At, 1, 0); PG8_STAGE(PG8_SA(0, 1), a2 + hstep, voffA);
            PG8_WAIT_L(8); PG8_BAR; PG8_WAIT_L(0); PG8_MMA(0, 0, At, B0); PG8_BAR; PG8_SCHED;
            PG8_LDB(B1, 1, 1); PG8_STAGE(PG8_SB(1, 0), b3, voffB);
            PG8_BAR; PG8_WAIT_L(0); PG8_MMA(0, 1, At, B1); PG8_BAR;
            PG8_LDA(At, 1, 1); PG8_STAGE(PG8_SA(1, 0), a3, voffA);
            PG8_BAR; PG8_WAIT_L(0); PG8_MMA(1, 0, At, B0); PG8_BAR; PG8_SCHED;
            PG8_STAGE(PG8_SB(1, 1), b3 + hstep, voffB);
            PG8_WAIT_V(6); PG8_BAR; PG8_MMA(1, 1, At, B1); PG8_BAR;
            }
        }
        if constexpr (ALIGN_EPI) { if (wr == 0) PG8_BAR; }
        if constexpr (!Epi::AFTER_DRAIN) { E(acc, cur, wr, wc, fr, fq); S.done(cur); }
        if (!has_next) break;
#pragma unroll
        for (int a = 0; a < 2; ++a)
#pragma unroll
            for (int b = 0; b < 2; ++b)
#pragma unroll
                for (int m = 0; m < 4; ++m)
#pragma unroll
                    for (int n = 0; n < 2; ++n) acc[a][b][m][n] = (f32x4){0.f, 0.f, 0.f, 0.f};
        cur = nxt; cA = nA; cB = nB; ++ui;
        if constexpr (ALIGN_EPI) { if (wr == 1) PG8_BAR; }
    }
    PG8_WAIT_V(0);
    if constexpr (!ALIGN_EPI) { if (wr == 0) PG8_BAR; }
    PG8_BAR;
    if constexpr (Epi::AFTER_DRAIN) { E.fused(acc, cur, wr, wc, fr, fq, lds, wid, lane); S.done(cur); }
#undef PG8_SA
#undef PG8_SB
#undef PG8_STAGE
#undef PG8_LDA
#undef PG8_LDB
#undef PG8_MMA
#undef PG8_WAIT_V
#undef PG8_WAIT_L
#undef PG8_BAR
#undef PG8_SCHED
}
}
#define GAS __attribute__((address_space(1)))
#define LAS __attribute__((address_space(3)))
typedef unsigned short bf16;
typedef unsigned v4u __attribute__((ext_vector_type(4)));
typedef float f32x4 __attribute__((ext_vector_type(4)));
typedef short bf16x8 __attribute__((ext_vector_type(8)));
typedef GAS unsigned gu32;
typedef GAS unsigned long long gu64;
#define RLX_AGENT __ATOMIC_RELAXED, __HIP_MEMORY_SCOPE_AGENT
#define LDS_WAIT() asm volatile("s_waitcnt lgkmcnt(0)" ::: "memory")
#define VM_WAIT() asm volatile("s_waitcnt vmcnt(0)" ::: "memory")
__device__ __forceinline__ unsigned long long rt() { return __builtin_amdgcn_s_memrealtime(); }
__device__ __forceinline__ unsigned f2bf(float f) { unsigned u = __builtin_bit_cast(unsigned, f); return (u + 0x7fffu + ((u >> 16) & 1u)) >> 16; }
__device__ __forceinline__ unsigned pk2(float lo, float hi) { return f2bf(lo) | (f2bf(hi) << 16); }

#define XB_TMO      128
#define XB_XCNT(j)  (256  + 64 * (j))
#define XB_XSUB(j)  (1280 + 64 * (j))
#define XB_XGEN(j)  (2304 + 64 * (j))
#define XB_TOP      3328
#define XB_TOPGEN   3392
#define XCD_BAR_WORDS 3456
#define XB_SPIN_CAP (1u << 18)

__device__ __forceinline__ unsigned xb_ld(unsigned* p)              { return __hip_atomic_load(p, __ATOMIC_RELAXED, __HIP_MEMORY_SCOPE_AGENT); }
__device__ __forceinline__ unsigned xb_add(unsigned* p, unsigned v) { return __hip_atomic_fetch_add(p, v, __ATOMIC_RELAXED, __HIP_MEMORY_SCOPE_AGENT); }
__device__ __forceinline__ unsigned xb_xcc_id() { return (unsigned)__builtin_amdgcn_s_getreg((3 << 11) | 20) & 0xFu; }
#define XB_SPIN(cond, bar) do { unsigned _sp = 0; while (cond) { __builtin_amdgcn_s_sleep(1); \
    if ((++_sp & 255u) == 0u) { if (xb_ld(&(bar)[XB_TMO])) break; if (_sp > XB_SPIN_CAP) { atomicAdd(&(bar)[XB_TMO], 1u); break; } } } } while (0)

struct XcdBarrier {
    unsigned* bar; unsigned x;
    volatile LAS unsigned* st;
};

__device__ __forceinline__ XcdBarrier xcd_barrier_post(unsigned* bar, volatile LAS unsigned* st) {
    XcdBarrier b; b.bar = bar; b.x = xb_xcc_id(); b.st = st;
    if (threadIdx.x == 0) (void)xb_add(&bar[XB_XCNT(b.x)], 1u);
    return b;
}
__device__ __forceinline__ void xcd_barrier_complete(unsigned* bar, unsigned x, unsigned& nloc, unsigned& nx) {
    const unsigned G = gridDim.x * gridDim.y * gridDim.z;
    unsigned sum, cnt, mine, sp = 0u;
    for (;;) {
        sum = 0u; cnt = 0u; mine = 0u;
#pragma unroll
        for (unsigned j = 0; j < 16; ++j) { const unsigned c = xb_ld(&bar[XB_XCNT(j)]); sum += c; cnt += (c > 0u) ? 1u : 0u; mine = (j == x) ? c : mine; }
        if (sum == G) break;
        __builtin_amdgcn_s_sleep(1);
        if ((++sp & 255u) == 0u) { if (xb_ld(&bar[XB_TMO])) break; if (sp > XB_SPIN_CAP) { atomicAdd(&bar[XB_TMO], 1u); break; } }
    }
    nloc = mine > 0u ? mine : 1u; nx = cnt > 0u ? cnt : 1u;
}

__device__ __forceinline__ void xcd_barrier(const XcdBarrier& b) {
    asm volatile("s_waitcnt vmcnt(0)" ::: "memory");
    __syncthreads();
    if (threadIdx.x == 0) {
        unsigned* bar = b.bar;
        __builtin_amdgcn_s_waitcnt(0);
        unsigned nloc = b.st[0], nx = b.st[1];
        if (nloc == 0u) { xcd_barrier_complete(bar, b.x, nloc, nx); b.st[0] = nloc; b.st[1] = nx; }
        const unsigned old = xb_add(&bar[XB_XSUB(b.x)], 1u);
        const unsigned gen = old / nloc;
        if (old + 1u == (gen + 1u) * nloc) {
            __builtin_amdgcn_fence(__ATOMIC_RELEASE, "agent");
            asm volatile("s_waitcnt vmcnt(0)" ::: "memory");
            const unsigned og = xb_add(&bar[XB_TOP], 1u);
            const unsigned tg = og / nx;
            if (og + 1u == (tg + 1u) * nx) xb_add(&bar[XB_TOPGEN], 1u);
            else XB_SPIN(xb_ld(&bar[XB_TOPGEN]) == tg, bar);
            __builtin_amdgcn_fence(__ATOMIC_ACQUIRE, "agent");
            xb_add(&bar[XB_XGEN(b.x)], 1u);
            asm volatile("s_waitcnt vmcnt(0)" ::: "memory");
        } else {
            XB_SPIN(xb_ld(&bar[XB_XGEN(b.x)]) == gen, bar);
            __builtin_amdgcn_fence(__ATOMIC_ACQUIRE, "agent");
            asm volatile("s_waitcnt vmcnt(0)" ::: "memory");
        }
    }
    __syncthreads();
}
constexpr int NWAVES = 8;
constexpr int NB = 16, SEQ = 2048, DM = 1024, M = NB * SEQ;
constexpr int NPROJ = 5120, QKVW = 1536;
constexpr int NH = 4, HD = 64, VD = 128;
constexpr int SSMW = 512, NG = 32, GH = 16, NP = 64;
constexpr float EPS = 1e-6f, LOG2E = 1.4426950408889634f, QSCALE = 0.125f * LOG2E;
constexpr float LAM_INIT = 0.2f;
constexpr int KSL = 8;

constexpr size_t MiB = 1u << 20;
constexpr size_t WS_CTL = 0, CTL_ZERO_BYTES = 1 * MiB;
constexpr size_t WS_MODP = 1 * MiB;
constexpr size_t WS_GATE = 3 * MiB;
constexpr size_t WS_ROPE = 4 * MiB;
constexpr size_t WS_WIN = 6 * MiB, WS_WGLU = 16 * MiB, WS_WUPA = 17 * MiB, WS_WUPS = 18 * MiB, WS_WOUT = 19 * MiB;
constexpr size_t WS_SSMT = 22 * MiB;
constexpr size_t WS_H = 40 * MiB;
constexpr size_t WS_AIN = 40 * MiB, WS_Y = 72 * MiB;
constexpr size_t WS_QKV = 104 * MiB;
constexpr size_t WS_ZA = 200 * MiB, WS_U = 232 * MiB, WS_ZS = 264 * MiB;
constexpr size_t WS_Y2 = WS_U;
constexpr size_t WS_GA = 296 * MiB, WS_GS = 360 * MiB;
constexpr size_t WS_YTMP = 424 * MiB;
constexpr size_t WS_END = 488 * MiB;
constexpr int CW_TMO = 0, CW_BAR = 4096, CW_ROWSS = 65536;
static_assert((CW_ROWSS + M) * 4 <= (int)CTL_ZERO_BYTES, "ctl");

constexpr int RING_OFF = 0, RING_BYTES = 139264;
constexpr int LDSCTL_OFF = RING_BYTES, MISC_OFF = LDSCTL_OFF + 320;
constexpr int LDS_BYTES = RING_BYTES + 1024;
struct Frame {
    LAS unsigned char* lds;
    volatile LAS unsigned* MISC;
    gu32* ctl;
    int tid, lane, wave;
    int vcu, G;
    const float* in[23]; float* out; unsigned char* ws;
};
__device__ __forceinline__ float wave_sum(float v) {
#pragma unroll
    for (int o = 1; o < 64; o <<= 1) v += __shfl_xor(v, o);
    return v;
}
__device__ __forceinline__ float sigm(float x) { return __builtin_amdgcn_rcpf(1.0f + __builtin_amdgcn_exp2f(-LOG2E * x)); }
__device__ __forceinline__ float bflo(unsigned w) { return __uint_as_float(w << 16); }
__device__ __forceinline__ float bfhi(unsigned w) { return __uint_as_float(w & 0xffff0000u); }
__device__ __forceinline__ float sin_rev(float ang) { float r = ang * 0.15915494309189535f; r -= floorf(r); return __builtin_amdgcn_sinf(r); }
__device__ __forceinline__ float cos_rev(float ang) { float r = ang * 0.15915494309189535f; r -= floorf(r); return __builtin_amdgcn_cosf(r); }

__device__ __forceinline__ void p0_transpose_item(const float* W, int K, int N, bf16* WT, LAS float* scr, int item, int lane) {
    const int nblk = N / 32, kb = item / nblk, nb = item % nblk, k0 = 64 * kb, n0 = 32 * nb;
#pragma unroll 8
    for (int i = 0; i < 32; ++i) { const int kk = 2 * i + (lane >> 5); scr[kk * 33 + (lane & 31)] = W[(size_t)(k0 + kk) * N + n0 + (lane & 31)]; }
    LDS_WAIT(); asm volatile("" ::: "memory");
    const int c = lane & 7;
#pragma unroll
    for (int j = 0; j < 4; ++j) { const int n = (lane >> 3) + 8 * j; const LAS float* s = scr + (8 * c) * 33 + n;
        v4u o; o.x = pk2(s[0 * 33], s[1 * 33]); o.y = pk2(s[2 * 33], s[3 * 33]); o.z = pk2(s[4 * 33], s[5 * 33]); o.w = pk2(s[6 * 33], s[7 * 33]);
        *(GAS v4u*)(WT + (size_t)(n0 + n) * K + k0 + 8 * c) = o; }
    LDS_WAIT(); asm volatile("" ::: "memory");
}
__device__ __forceinline__ void p0_prologue(Frame& F) {
    LAS float* scr = (LAS float*)(F.lds + RING_OFF + F.wave * 16384);
    const int gw = F.vcu * NWAVES + F.wave, NGW = F.G * NWAVES;
    constexpr int I_IN = (DM / 64) * (NPROJ / 32), I_GLU = (512 / 64) * (512 / 32), I_UP = (512 / 64) * (DM / 32), I_OUT = (DM / 64) * (DM / 32);
    constexpr int I_MOD = 48 * KSL;
    constexpr int NITEMS = I_IN + I_GLU + 2 * I_UP + I_OUT + I_MOD;
    bf16* ws16 = (bf16*)F.ws;
    for (int it = gw; it < NITEMS; it += NGW) {
        int r = it;
        if (r < I_MOD) {
            const int cg = r / KSL, ks = r % KSL, n = cg * 64 + F.lane, k0 = ks * 128;
            const float* c = F.in[1]; const float* wa = F.in[3];
            for (int i = F.lane; i < 16 * 128; i += 64) { const int b = i >> 7, k = i & 127; const float cv = c[b * DM + k0 + k]; scr[i] = cv * sigm(cv); }
            LDS_WAIT(); asm volatile("" ::: "memory");
            float acc[16];
#pragma unroll
            for (int b = 0; b < 16; ++b) acc[b] = 0.f;
            for (int k = 0; k < 128; ++k) { const float w = wa[(size_t)(k0 + k) * 3072 + n];
#pragma unroll
                for (int b = 0; b < 16; ++b) acc[b] += scr[b * 128 + k] * w; }
            float* mp = (float*)(F.ws + WS_MODP) + (size_t)ks * 16 * 3072;
#pragma unroll
            for (int b = 0; b < 16; ++b) mp[b * 3072 + n] = acc[b];
            LDS_WAIT(); asm volatile("" ::: "memory");
            continue; }
        r -= I_MOD;
        if (r < I_IN) { p0_transpose_item(F.in[6], DM, NPROJ, ws16 + WS_WIN / 2, scr, r, F.lane); continue; } r -= I_IN;
        if (r < I_GLU) { p0_transpose_item(F.in[17], 512, 512, ws16 + WS_WGLU / 2, scr, r, F.lane); continue; } r -= I_GLU;
        if (r < I_UP) { p0_transpose_item(F.in[19], 512, DM, ws16 + WS_WUPA / 2, scr, r, F.lane); continue; } r -= I_UP;
        if (r < I_UP) { p0_transpose_item(F.in[20], 512, DM, ws16 + WS_WUPS / 2, scr, r, F.lane); continue; } r -= I_UP;
        p0_transpose_item(F.in[21], DM, DM, ws16 + WS_WOUT / 2, scr, r, F.lane);
    }
    { const int* pos = (const int*)F.in[2]; float* rope = (float*)(F.ws + WS_ROPE);
      for (int idx = (F.vcu * 512 + F.tid); idx < M * 8; idx += F.G * 512) { const int tok = idx >> 3, i = idx & 7;
          const float invf = __builtin_amdgcn_exp2f(-(float)i * (18.931568569324174f / 8.0f));
          const float ang = (float)pos[tok] * invf;
          rope[tok * 16 + i] = cos_rev(ang); rope[tok * 16 + 8 + i] = sin_rev(ang); } }
}

__device__ __forceinline__ void p1a_norm(Frame& F) {
    LAS float* gs = (LAS float*)(F.lds + RING_OFF); LAS float* sh = gs + 1024;
    const float* modp = (const float*)(F.ws + WS_MODP); const float* b_ada = F.in[4]; const float* g_pre = F.in[5];
    const int rows_per = M / F.G;
    const int r0 = F.vcu * rows_per, b = r0 / SEQ;
    for (int k = F.tid; k < 1024; k += 512) {
        float s_sh = b_ada[k], s_sc = b_ada[1024 + k];
#pragma unroll
        for (int ks = 0; ks < KSL; ++ks) { s_sh += modp[((size_t)ks * 16 + b) * 3072 + k]; s_sc += modp[((size_t)ks * 16 + b) * 3072 + 1024 + k]; }
        gs[k] = g_pre[k] * (1.0f + s_sc); sh[k] = s_sh; }
    { const int sub = (r0 % SEQ) / rows_per;
      if (F.tid < 64 && sub < 16) { const int k = sub * 64 + F.tid; float s = b_ada[2048 + k];
#pragma unroll
          for (int ks = 0; ks < KSL; ++ks) s += modp[((size_t)ks * 16 + b) * 3072 + 2048 + k];
          ((float*)(F.ws + WS_GATE))[b * 1024 + k] = s; } }
    LDS_WAIT(); __syncthreads();
    bf16* H = (bf16*)(F.ws + WS_H);
    for (int r = r0 + F.wave; r < r0 + rows_per; r += NWAVES) {
        const GAS f32x4* xr = (const GAS f32x4*)(F.in[0] + (size_t)r * DM) + F.lane;
        f32x4 v[4]; float s = 0.f;
#pragma unroll
        for (int j = 0; j < 4; ++j) { v[j] = xr[64 * j]; s += (v[j].x * v[j].x + v[j].y * v[j].y) + (v[j].z * v[j].z + v[j].w * v[j].w); }
        const float inv = 1.0f / sqrtf(wave_sum(s) * (1.f / DM) + EPS);
        GAS unsigned long long* o8 = (GAS unsigned long long*)(H + (size_t)r * DM) + F.lane;
#pragma unroll
        for (int j = 0; j < 4; ++j) { const int k = 4 * F.lane + 256 * j; const f32x4 g = *(const LAS f32x4*)(gs + k), s4 = *(const LAS f32x4*)(sh + k);
            const f32x4 h = v[j] * inv * g + s4;
            o8[64 * j] = (unsigned long long)pk2(h.x, h.y) | ((unsigned long long)pk2(h.z, h.w) << 32); }
    }
    __syncthreads();
}

__device__ __forceinline__ void attn_naive_unit(Frame& F, int unit) {
    const int qb = unit & 31, bh = unit >> 5, h = bh & 3, b = bh >> 2;
    const int t = F.tid, row = t & 63, c = (t >> 6) & 1, dq = t >> 7;
    const bf16* QKV = (const bf16*)(F.ws + WS_QKV);
    LAS unsigned char* Kl = F.lds + RING_OFF; LAS unsigned char* Vl = Kl + 8192; LAS float* X = (LAS float*)(F.lds + RING_OFF + 32768); LAS float* SS = X + 64 * 128;
    float q[64];
    { const v4u* qp = (const v4u*)(QKV + (size_t)(b * SEQ + qb * 64 + row) * QKVW + h * 128 + c * 64);
#pragma unroll
      for (int i = 0; i < 8; ++i) { const v4u w = qp[i]; q[8 * i] = bflo(w.x); q[8 * i + 1] = bfhi(w.x); q[8 * i + 2] = bflo(w.y); q[8 * i + 3] = bfhi(w.y);
          q[8 * i + 4] = bflo(w.z); q[8 * i + 5] = bfhi(w.z); q[8 * i + 6] = bflo(w.w); q[8 * i + 7] = bfhi(w.w); } }
    float o[32];
#pragma unroll
    for (int j = 0; j < 32; ++j) o[j] = 0.f;
    float mrun = -1e30f, l = 0.f;
    const int lk = t >> 4, lc = t & 15;
    for (int kt = 0; kt < SEQ / 32; ++kt) {
        __syncthreads();
        { const size_t rowoff = (size_t)(b * SEQ + kt * 32 + lk) * QKVW + h * 128 + lc * 8;
          *(LAS v4u*)(Kl + lk * 256 + lc * 16) = *(const v4u*)(QKV + rowoff + 512);
          *(LAS v4u*)(Vl + lk * 256 + lc * 16) = *(const v4u*)(QKV + rowoff + 1024); }
        LDS_WAIT(); __syncthreads();
#pragma unroll 1
        for (int key = 0; key < 32; ++key) {
            const LAS unsigned char* Kg = Kl + key * 256 + c * 128; const LAS unsigned char* Vg = Vl + key * 256 + dq * 64;
            float a = 0.f;
#pragma unroll
            for (int i = 0; i < 8; ++i) { const v4u w = *(const LAS v4u*)(Kg + i * 16);
                a += q[8 * i] * bflo(w.x) + q[8 * i + 1] * bfhi(w.x) + q[8 * i + 2] * bflo(w.y) + q[8 * i + 3] * bfhi(w.y)
                   + q[8 * i + 4] * bflo(w.z) + q[8 * i + 5] * bfhi(w.z) + q[8 * i + 6] * bflo(w.w) + q[8 * i + 7] * bfhi(w.w); }
            const float mn = fmaxf(mrun, a), alpha = __builtin_amdgcn_exp2f(mrun - mn), p = __builtin_amdgcn_exp2f(a - mn); mrun = mn;
            l = l * alpha + p;
#pragma unroll
            for (int i = 0; i < 4; ++i) { const v4u w = *(const LAS v4u*)(Vg + i * 16);
                o[8 * i] = o[8 * i] * alpha + p * bflo(w.x); o[8 * i + 1] = o[8 * i + 1] * alpha + p * bfhi(w.x); o[8 * i + 2] = o[8 * i + 2] * alpha + p * bflo(w.y); o[8 * i + 3] = o[8 * i + 3] * alpha + p * bfhi(w.y);
                o[8 * i + 4] = o[8 * i + 4] * alpha + p * bflo(w.z); o[8 * i + 5] = o[8 * i + 5] * alpha + p * bfhi(w.z); o[8 * i + 6] = o[8 * i + 6] * alpha + p * bflo(w.w); o[8 * i + 7] = o[8 * i + 7] * alpha + p * bfhi(w.w); }
        }
    }
    const float rl = 1.0f / l;
    float lam; { const float* lq = F.in[7]; float d1 = 0.f, d2 = 0.f; for (int i = 0; i < 64; ++i) { d1 += lq[i] * lq[64 + i]; d2 += lq[128 + i] * lq[192 + i]; } lam = __expf(d1) - __expf(d2) + LAM_INIT; }
    __syncthreads();
    if (c == 1) {
#pragma unroll
        for (int j = 0; j < 32; ++j) X[row * 128 + dq * 32 + j] = o[j] * rl; }
    LDS_WAIT(); __syncthreads();
    float ss = 0.f;
    if (c == 0) {
#pragma unroll
        for (int j = 0; j < 32; ++j) { o[j] = o[j] * rl - lam * X[row * 128 + dq * 32 + j]; ss += o[j] * o[j]; }
        SS[row * 4 + dq] = ss; }
    LDS_WAIT(); __syncthreads();
    if (c == 0) {
        const float inv = 1.0f / sqrtf(((SS[row * 4] + SS[row * 4 + 1]) + (SS[row * 4 + 2] + SS[row * 4 + 3])) * (1.0f / 128.0f) + EPS) * (1.0f - LAM_INIT);
        const float* gsub = F.in[8]; const size_t tok = (size_t)(b * SEQ + qb * 64 + row);
        const v4u* zp = (const v4u*)((const bf16*)(F.ws + WS_ZA) + tok * 512 + h * 128 + dq * 32);
        v4u* op = (v4u*)((bf16*)(F.ws + WS_AIN) + tok * 512 + h * 128 + dq * 32);
#pragma unroll
        for (int i = 0; i < 4; ++i) { const v4u z = zp[i]; float r[8];
#pragma unroll
            for (int e = 0; e < 8; ++e) r[e] = o[8 * i + e] * inv * gsub[dq * 32 + 8 * i + e];
            r[0] *= bflo(z.x); r[1] *= bfhi(z.x); r[2] *= bflo(z.y); r[3] *= bfhi(z.y); r[4] *= bflo(z.z); r[5] *= bfhi(z.z); r[6] *= bflo(z.w); r[7] *= bfhi(z.w);
            v4u w; w.x = pk2(r[0], r[1]); w.y = pk2(r[2], r[3]); w.z = pk2(r[4], r[5]); w.w = pk2(r[6], r[7]); op[i] = w; } }
    __syncthreads();
}

__device__ __forceinline__ float gelu_tanh(float x) { const float u = 0.7978845608028654f * (x + 0.044715f * x * x * x); const float e = __builtin_amdgcn_exp2f(2.0f * LOG2E * u); const float th = 1.0f - 2.0f * __builtin_amdgcn_rcpf(e + 1.0f); return 0.5f * x * (1.0f + th); }
__device__ __forceinline__ void ssm_naive_unit(Frame& F, int unit) {
    const int g = unit & 31, b = unit >> 5, p = F.lane;
    const bf16* U = (const bf16*)(F.ws + WS_U); float* YT = (float*)(F.ws + WS_YTMP); bf16* Y = (bf16*)(F.ws + WS_Y);
    const float* dsk = F.in[16];
    for (int d = 0; d < 2; ++d) {
        const int pg = (d * NG + g);
        const float dt = __expf(F.in[11][pg]);
        const float lr = fminf(F.in[9][pg * NP + p], -1e-4f), li = F.in[10][pg * NP + p];
        const float mag = __expf(lr * dt); const float are = mag * cos_rev(li * dt), aim = mag * sin_rev(li * dt);
        const float den = lr * lr + li * li, nr = are - 1.0f, ni = aim; const float cre_ = (nr * lr + ni * li) / den, cim_ = (ni * lr - nr * li) / den;
        float bre[16], bim[16], cre[16], cim[16];
#pragma unroll
        for (int h = 0; h < 16; ++h) { const float br = F.in[12][((size_t)pg * NP + p) * GH + h], bi = F.in[13][((size_t)pg * NP + p) * GH + h];
            bre[h] = cre_ * br - cim_ * bi; bim[h] = cre_ * bi + cim_ * br;
            cre[h] = F.in[14][((size_t)pg * GH + h) * NP + p]; cim[h] = F.in[15][((size_t)pg * GH + h) * NP + p]; }
        float xr = 0.f, xi = 0.f;
        const int hsel = ((p >> 5) & 1) * 8 + ((p >> 4) & 1) * 4 + ((p >> 3) & 1) * 2 + ((p >> 2) & 1);
        const float dv = dsk[g * GH + hsel];
        for (int st = 0; st < SEQ; ++st) {
            const int t = d ? (SEQ - 1 - st) : st; const size_t tok = (size_t)b * SEQ + t;
            const v4u* up = (const v4u*)(U + tok * SSMW + g * GH); const v4u w0 = up[0], w1 = up[1];
            float u[16]; u[0] = bflo(w0.x); u[1] = bfhi(w0.x); u[2] = bflo(w0.y); u[3] = bfhi(w0.y); u[4] = bflo(w0.z); u[5] = bfhi(w0.z); u[6] = bflo(w0.w); u[7] = bfhi(w0.w);
            u[8] = bflo(w1.x); u[9] = bfhi(w1.x); u[10] = bflo(w1.y); u[11] = bfhi(w1.y); u[12] = bflo(w1.z); u[13] = bfhi(w1.z); u[14] = bflo(w1.w); u[15] = bfhi(w1.w);
            float br = 0.f, bi = 0.f;
#pragma unroll
            for (int h = 0; h < 16; ++h) { br += bre[h] * u[h]; bi += bim[h] * u[h]; }
            const float nxr = are * xr - aim * xi + br, nxi = are * xi + aim * xr + bi; xr = nxr; xi = nxi;
            float v[16];
#pragma unroll
            for (int h = 0; h < 16; ++h) v[h] = cre[h] * xr - cim[h] * xi;
            float w8[8], w4[4], w2[2], w1_;
            { const bool hi = (p & 32) != 0;
#pragma unroll
              for (int k = 0; k < 8; ++k) { const float send = hi ? v[k] : v[k + 8], keep = hi ? v[k + 8] : v[k]; w8[k] = keep + __shfl_xor(send, 32); } }
            { const bool hi = (p & 16) != 0;
#pragma unroll
              for (int k = 0; k < 4; ++k) { const float send = hi ? w8[k] : w8[k + 4], keep = hi ? w8[k + 4] : w8[k]; w4[k] = keep + __shfl_xor(send, 16); } }
            { const bool hi = (p & 8) != 0;
#pragma unroll
              for (int k = 0; k < 2; ++k) { const float send = hi ? w4[k] : w4[k + 2], keep = hi ? w4[k + 2] : w4[k]; w2[k] = keep + __shfl_xor(send, 8); } }
            { const bool hi = (p & 4) != 0; const float send = hi ? w2[0] : w2[1], keep = hi ? w2[1] : w2[0]; w1_ = keep + __shfl_xor(send, 4); }
            w1_ += __shfl_xor(w1_, 2); w1_ += __shfl_xor(w1_, 1);
            if ((p & 3) == 0) {
                if (d == 0) YT[tok * SSMW + g * GH + hsel] = w1_;
                else { const float uh = __uint_as_float((unsigned)U[tok * SSMW + g * GH + hsel] << 16);
                       const float y = YT[tok * SSMW + g * GH + hsel] + w1_ + dv * uh; Y[tok * SSMW + g * GH + hsel] = (bf16)f2bf(gelu_tanh(y)); } }
        }
        asm volatile("s_waitcnt vmcnt(0)" ::: "memory");
    }
}

__device__ __forceinline__ void p6_final_norm(Frame& F) {
    const int gw = F.vcu * NWAVES + F.wave, NGW = F.G * NWAVES;
    const float* rowss = (const float*)(F.ctl + CW_ROWSS); const float* gf = F.in[22];
    f32x4 g4[4];
#pragma unroll
    for (int j = 0; j < 4; ++j) g4[j] = *(const f32x4*)(gf + 4 * F.lane + 256 * j);
    for (int r = gw; r < M; r += NGW) { const float inv = 1.0f / sqrtf(rowss[r] * (1.f / DM) + EPS);
        GAS f32x4* o = (GAS f32x4*)(F.out + (size_t)r * DM) + F.lane;
#pragma unroll
        for (int j = 0; j < 4; ++j) o[64 * j] = o[64 * j] * inv * g4[j]; }
}
namespace att {
using bf16x8 = __attribute__((ext_vector_type(8))) short;
using s16x4  = __attribute__((ext_vector_type(4))) short;
using f32x16 = __attribute__((ext_vector_type(16))) float;
using u32x4  = __attribute__((ext_vector_type(4))) unsigned;
constexpr int QBLK = 32, KVBLK = 64, LDR = QKVW;
constexpr size_t SHM_V = KVBLK * 128 * 2, SHM_K = KVBLK * 128 * 2, SHM_ATTN = 2 * SHM_V + 2 * SHM_K + NWAVES * 64 * 4;
constexpr float THRL = 8.f * LOG2E;
#define KSWZ(row, colB) ((row) * 256 + ((colB) ^ (((row) & 7) << 4)))
#define SBAR() __builtin_amdgcn_sched_barrier(0)
__device__ __forceinline__ int crow(int r, int hi) { return (r & 3) + 8 * (r >> 2) + 4 * hi; }
__device__ __forceinline__ unsigned cvtpk(float lo, float hi) { unsigned r; asm volatile("v_cvt_pk_bf16_f32 %0, %1, %2" : "=v"(r) : "v"(lo), "v"(hi)); return r; }
__device__ __forceinline__ void partialSM(f32x16& p0, f32x16& p1, float& m_reg, float& mn, float& alpha) {
  float pmax = p0[0];
#pragma unroll
  for (int r = 1; r < 16; ++r) pmax = fmaxf(pmax, p0[r]);
#pragma unroll
  for (int r = 0; r < 16; ++r) pmax = fmaxf(pmax, p1[r]);
  { auto rr = __builtin_amdgcn_permlane32_swap(__float_as_uint(pmax), __float_as_uint(pmax), false, false);
    pmax = fmaxf(__uint_as_float(rr[0]), __uint_as_float(rr[1])); }
  if (__builtin_expect(__all(pmax - m_reg <= THRL), 1)) { mn = m_reg; alpha = 1.f; }
  else { mn = fmaxf(m_reg, pmax); alpha = __builtin_amdgcn_exp2f(m_reg - mn); m_reg = mn; }
#pragma unroll
  for (int r = 0; r < 16; ++r) p0[r] -= mn;
#pragma unroll
  for (int r = 0; r < 16; ++r) p1[r] -= mn;
#pragma unroll
  for (int r = 0; r < 16; ++r) p0[r] = __builtin_amdgcn_exp2f(p0[r]);
}
__device__ __forceinline__ void finishSM(f32x16& p0, f32x16& p1, float alpha, float& l_reg, bf16x8& pa0, bf16x8& pa1, bf16x8& pa2, bf16x8& pa3) {
#pragma unroll
  for (int r = 0; r < 16; ++r) p1[r] = __builtin_amdgcn_exp2f(p1[r]);
  float ps = 0;
#pragma unroll
  for (int r = 0; r < 16; ++r) ps += p0[r];
#pragma unroll
  for (int r = 0; r < 16; ++r) ps += p1[r];
  { auto rr = __builtin_amdgcn_permlane32_swap(__float_as_uint(ps), __float_as_uint(ps), false, false);
    ps = __uint_as_float(rr[0]) + __uint_as_float(rr[1]); }
  l_reg = l_reg * alpha + ps;
#define PK4(P, BASE, OUT) do { unsigned a0 = cvtpk(P[BASE + 0], P[BASE + 1]), a1 = cvtpk(P[BASE + 2], P[BASE + 3]);   \
    unsigned b0 = cvtpk(P[BASE + 4], P[BASE + 5]), b1 = cvtpk(P[BASE + 6], P[BASE + 7]);                              \
    auto r0 = __builtin_amdgcn_permlane32_swap(a0, b0, false, false); auto r1 = __builtin_amdgcn_permlane32_swap(a1, b1, false, false); \
    u32x4 w = {r0[0], r1[0], r0[1], r1[1]}; OUT = *reinterpret_cast<bf16x8*>(&w); } while (0)
  PK4(p0, 0, pa0); PK4(p0, 8, pa1); PK4(p1, 0, pa2); PK4(p1, 8, pa3);
#undef PK4
}
__device__ __forceinline__ void qkt(f32x16& p0, f32x16& p1, const char* Ks, const bf16x8* qr, int r32, int hi, int cofs) {
  p0 = f32x16{}; p1 = f32x16{};
#pragma unroll
  for (int d0 = 0; d0 < 4; ++d0) { const int cb = cofs + (d0 * 16 + hi * 8) * 2;
    const bf16x8 b0 = *reinterpret_cast<const bf16x8*>(Ks + KSWZ(r32, cb));
    const bf16x8 b1 = *reinterpret_cast<const bf16x8*>(Ks + KSWZ(32 + r32, cb));
    p0 = __builtin_amdgcn_mfma_f32_32x32x16_bf16(b0, qr[d0], p0, 0, 0, 0);
    p1 = __builtin_amdgcn_mfma_f32_32x32x16_bf16(b1, qr[d0], p1, 0, 0, 0); }
}
__device__ __forceinline__ int v_st(int k, int c) { const int kk = (k & ~0xC) | ((k & 4) << 1) | ((k & 8) >> 1); return ((kk >> 3) * 4 + (c >> 5)) * 512 + ((kk & 7) * 32 + (c & 31)) * 2; }
__device__ __forceinline__ int v_rd_base(int lane) { return ((lane & 3) << 3) | (((lane >> 2) & 3) << 6) | (((lane >> 4) & 1) << 5) | (((lane >> 5) & 1) << 8); }
constexpr int v_rd_off(int d0, int ks, int half) { return d0 * 512 + ks * 4096 + half * 2048; }
template <int OFF> __device__ __forceinline__ s16x4 tr_read(int vb) {
  s16x4 r; asm volatile("ds_read_b64_tr_b16 %0, %1 offset:%2" : "=&v"(r) : "v"(vb), "i"(OFF) : "memory"); return r;
}
template <int D0> __device__ __forceinline__ void pv_one(f32x16& od, int vb, bf16x8 pa0, bf16x8 pa1, bf16x8 pa2, bf16x8 pa3) {
  const s16x4 l0 = tr_read<v_rd_off(D0, 0, 0)>(vb), h0 = tr_read<v_rd_off(D0, 0, 1)>(vb), l1 = tr_read<v_rd_off(D0, 1, 0)>(vb), h1 = tr_read<v_rd_off(D0, 1, 1)>(vb);
  const s16x4 l2 = tr_read<v_rd_off(D0, 2, 0)>(vb), h2 = tr_read<v_rd_off(D0, 2, 1)>(vb), l3 = tr_read<v_rd_off(D0, 3, 0)>(vb), h3 = tr_read<v_rd_off(D0, 3, 1)>(vb);
  asm volatile("s_waitcnt lgkmcnt(0)" ::: "memory"); SBAR();
#define PK(L, H) (bf16x8){L[0], L[1], L[2], L[3], H[0], H[1], H[2], H[3]}
  od = __builtin_amdgcn_mfma_f32_32x32x16_bf16(pa0, PK(l0, h0), od, 0, 0, 0);
  od = __builtin_amdgcn_mfma_f32_32x32x16_bf16(pa1, PK(l1, h1), od, 0, 0, 0);
  od = __builtin_amdgcn_mfma_f32_32x32x16_bf16(pa2, PK(l2, h2), od, 0, 0, 0);
  od = __builtin_amdgcn_mfma_f32_32x32x16_bf16(pa3, PK(l3, h3), od, 0, 0, 0);
#undef PK
}
__device__ __forceinline__ void pv_d0(f32x16* o, int vb, bf16x8 pa0, bf16x8 pa1, bf16x8 pa2, bf16x8 pa3) {
  pv_one<0>(o[0], vb, pa0, pa1, pa2, pa3); pv_one<1>(o[1], vb, pa0, pa1, pa2, pa3); pv_one<2>(o[2], vb, pa0, pa1, pa2, pa3); pv_one<3>(o[3], vb, pa0, pa1, pa2, pa3);
}
__device__ __forceinline__ void attn_unit(int b, int h, int qb, const unsigned short* __restrict__ QKVb, const unsigned short* __restrict__ ZA, unsigned short* __restrict__ AIN,
                                          const float* __restrict__ gsub, float lam, char* lds) {
  const int tid = threadIdx.x, wid = tid >> 6, lane = tid & 63, r32 = lane & 31, hi = lane >> 5, c = wid >> 2, wq = wid & 3;
  char* V_lds = lds; char* K_lds = lds + 2 * SHM_V;
  float* ws = (float*)(lds + 2 * SHM_V + 2 * SHM_K) + wid * 64; float* li_l = ws; float* al_l = ws + 32;
  float m_reg = -1e30f, l_reg = 0; f32x16 o[4] = {}; bf16x8 qr[4];
  const long tok0 = (long)b * SEQ + qb * 128;
  const unsigned short* Qw = QKVb + (tok0 + wq * QBLK + r32) * LDR + h * 128 + c * 64 + hi * 8;
#pragma unroll
  for (int d0 = 0; d0 < 4; ++d0) qr[d0] = *reinterpret_cast<const bf16x8*>(Qw + d0 * 16);
  const unsigned short* Kh = QKVb + (long)b * SEQ * LDR + 512 + h * 128; const unsigned short* Vh = Kh + 512;
  const int cofs = c * 128;
  const int sr = tid >> 4, sc = (tid & 15) * 8, vst0 = v_st(sr, sc), vst1 = v_st(32 + sr, sc);
  const int vb0 = (int)(uintptr_t)V_lds + v_rd_base(lane);
  struct { bf16x8 vs0, vs1, ks0, ks1; } sr_[2];
#define SLOAD(i, k0) do { sr_[i].vs0 = *reinterpret_cast<const bf16x8*>(&Vh[(long)((k0) + sr) * LDR + sc]); sr_[i].vs1 = *reinterpret_cast<const bf16x8*>(&Vh[(long)((k0) + 32 + sr) * LDR + sc]); \
    sr_[i].ks0 = *reinterpret_cast<const bf16x8*>(&Kh[(long)((k0) + sr) * LDR + sc]); sr_[i].ks1 = *reinterpret_cast<const bf16x8*>(&Kh[(long)((k0) + 32 + sr) * LDR + sc]); } while (0)
#define SWRITE(bb, i) do { *(bf16x8*)(V_lds + (bb) * SHM_V + vst0) = sr_[i].vs0;          \
    *(bf16x8*)(V_lds + (bb) * SHM_V + vst1) = sr_[i].vs1; const int kc = sc * 2;               \
    *(bf16x8*)(K_lds + (bb) * SHM_K + KSWZ(sr, kc)) = sr_[i].ks0;                       \
    *(bf16x8*)(K_lds + (bb) * SHM_K + KSWZ(32 + sr, kc)) = sr_[i].ks1; } while (0)
#define SWAIT() asm volatile("s_waitcnt vmcnt(4)" ::: "memory")
#define RESC(a) do { if (__any((a) < 1.f)) { if (hi == 0) al_l[r32] = (a); asm volatile("s_waitcnt lgkmcnt(0)" ::: "memory"); \
    _Pragma("unroll") for (int d = 0; d < 4; ++d) _Pragma("unroll") for (int r = 0; r < 16; ++r) o[d][r] *= al_l[crow(r, hi)]; } } while (0)
  f32x16 pA0, pA1, pB0, pB1; float mnA, mnB, alA, alB; bf16x8 pa0, pa1, pa2, pa3; constexpr int NT = SEQ / KVBLK;
  constexpr int SE = 0, SO = 1;
  SLOAD(SE, 0); asm volatile("s_waitcnt vmcnt(0)" ::: "memory"); SWRITE(0, SE); __syncthreads();
  qkt(pA0, pA1, K_lds, qr, r32, hi, cofs); partialSM(pA0, pA1, m_reg, mnA, alA);
  SLOAD(SO, KVBLK); SLOAD(SE, 2 * KVBLK);
  SWAIT(); SWRITE(1, SO); __syncthreads();
  for (int j = 1; j + 1 < NT; j += 2) {
    SBAR(); qkt(pB0, pB1, K_lds + SHM_K, qr, r32, hi, cofs);
    finishSM(pA0, pA1, alA, l_reg, pa0, pa1, pa2, pa3); SBAR();
    SLOAD(SO, (j + 2) * KVBLK); SBAR();
    pv_d0(o, vb0, pa0, pa1, pa2, pa3); partialSM(pB0, pB1, m_reg, mnB, alB);
    __syncthreads(); SWAIT(); SWRITE(0, SE);
    RESC(alB); __syncthreads();
    SBAR(); qkt(pA0, pA1, K_lds, qr, r32, hi, cofs);
    finishSM(pB0, pB1, alB, l_reg, pa0, pa1, pa2, pa3); SBAR();
    if (j + 3 < NT) SLOAD(SE, (j + 3) * KVBLK); SBAR();
    pv_d0(o, vb0 + (int)SHM_V, pa0, pa1, pa2, pa3); partialSM(pA0, pA1, m_reg, mnA, alA);
    __syncthreads(); SWAIT(); SWRITE(1, SO);
    RESC(alA); __syncthreads();
  }
  SBAR(); qkt(pB0, pB1, K_lds + SHM_K, qr, r32, hi, cofs);
  finishSM(pA0, pA1, alA, l_reg, pa0, pa1, pa2, pa3); SBAR();
  pv_d0(o, vb0, pa0, pa1, pa2, pa3); partialSM(pB0, pB1, m_reg, mnB, alB);
  __syncthreads(); RESC(alB);
  finishSM(pB0, pB1, alB, l_reg, pa0, pa1, pa2, pa3); SBAR();
  pv_d0(o, vb0 + (int)SHM_V, pa0, pa1, pa2, pa3);
  if (hi == 0) li_l[r32] = l_reg; asm volatile("s_waitcnt lgkmcnt(0)" ::: "memory");
  float rli[16];
#pragma unroll
  for (int r = 0; r < 16; ++r) rli[r] = __builtin_amdgcn_rcpf(li_l[crow(r, hi)]);
  float* X = (float*)lds + wq * (64 * 64);
  __syncthreads();
  if (c == 1) {
#pragma unroll
    for (int r = 0; r < 16; ++r)
#pragma unroll
      for (int d0 = 0; d0 < 4; ++d0) X[(r * 4 + d0) * 64 + lane] = o[d0][r] * rli[r];
  }
  __syncthreads();
  if (c == 0) {
#pragma unroll
    for (int r = 0; r < 16; ++r)
#pragma unroll
      for (int d0 = 0; d0 < 4; ++d0) o[d0][r] = o[d0][r] * rli[r] - lam * X[(r * 4 + d0) * 64 + lane];
  }
  __syncthreads();
  if (c == 0) {
    float gs[4];
#pragma unroll
    for (int d0 = 0; d0 < 4; ++d0) gs[d0] = gsub[d0 * 32 + r32] * (1.0f - LAM_INIT);
#pragma unroll
    for (int r = 0; r < 16; ++r) {
      float ss = (o[0][r] * o[0][r] + o[1][r] * o[1][r]) + (o[2][r] * o[2][r] + o[3][r] * o[3][r]);
#pragma unroll
      for (int off = 1; off < 32; off <<= 1) ss += __shfl_xor(ss, off);
      const float inv = 1.0f / sqrtf(ss * (1.0f / 128.0f) + EPS);
      const long tok = tok0 + wq * QBLK + crow(r, hi); const unsigned short* zp = ZA + tok * 512 + h * 128 + r32; unsigned short* op = AIN + tok * 512 + h * 128 + r32;
#pragma unroll
      for (int d0 = 0; d0 < 4; ++d0) { const float z = __uint_as_float((unsigned)zp[d0 * 32] << 16); op[d0 * 32] = (unsigned short)f2bf(o[d0][r] * inv * gs[d0] * z); }
    }
  }
#undef SLOAD
#undef SWRITE
#undef SWAIT
#undef RESC
}
#undef KSWZ
#undef SBAR
}
namespace ssm {
using bf16x8 = __attribute__((ext_vector_type(8))) short;
using f32x16 = __attribute__((ext_vector_type(16))) float;
constexpr int L = 32, NC = 64;
constexpr size_t WAF_G = 8 * 32 * 512, WCF_G = 16 * 16 * 512, KT_G = 16384;
constexpr int U_OFF = 0, U_CH = 1040, S_OFF = 66560, S_LD = 65, KT_OFF = S_OFF, X_OFF = S_OFF + 128 * S_LD * 4, X_CH = 528, LDS_NEED = X_OFF + 64 * X_CH;
struct Disc { float lr, li, dt, cre, cim; };
__device__ __forceinline__ Disc disc(const float* lam_re, const float* lam_im, const float* log_dt, int pg, int p) {
    Disc d; d.dt = __expf(log_dt[pg]); d.lr = fminf(lam_re[pg * NP + p], -1e-4f); d.li = lam_im[pg * NP + p];
    const float mag = __expf(d.lr * d.dt), are = mag * cos_rev(d.li * d.dt), aim = mag * sin_rev(d.li * d.dt);
    const float den = d.lr * d.lr + d.li * d.li, nr = are - 1.0f, ni = aim; d.cre = (nr * d.lr + ni * d.li) / den; d.cim = (ni * d.lr - nr * d.li) / den; return d;
}
__device__ __forceinline__ void apow(const Disc& d, int n, float& re, float& im) { const float mag = __expf((float)n * d.lr * d.dt), ang = (float)n * (d.li * d.dt); re = mag * cos_rev(ang); im = mag * sin_rev(ang); }

__device__ __forceinline__ void build_waf(const float* const* in, unsigned short* WAF, int piece) {
    const int lane = piece & 63, i = (piece >> 6) & 31, mb = (piece >> 11) & 7, g = piece >> 14;
    const int k = 32 * mb + (lane & 31), dir = k >> 7, ri = (k >> 6) & 1, p = k & 63, hh = 8 * (lane >> 5), pg = dir * NG + g;
    const Disc d = disc(in[9], in[10], in[11], pg, p); float pr, pi; apow(d, dir ? i : (L - 1 - i), pr, pi);
    const float zr = pr * d.cre - pi * d.cim, zi = pr * d.cim + pi * d.cre;
    const float* br = in[12] + ((size_t)pg * NP + p) * GH + hh; const float* bi = in[13] + ((size_t)pg * NP + p) * GH + hh;
    float v[8];
#pragma unroll
    for (int e = 0; e < 8; ++e) v[e] = ri ? (zr * bi[e] + zi * br[e]) : (zr * br[e] - zi * bi[e]);
    v4u w; w.x = pk2(v[0], v[1]); w.y = pk2(v[2], v[3]); w.z = pk2(v[4], v[5]); w.w = pk2(v[6], v[7]); *(v4u*)(WAF + (size_t)piece * 8) = w;
}
__device__ __forceinline__ void build_wcf(const float* const* in, unsigned short* WCF, int piece) {
    const int lane = piece & 63, ks = (piece >> 6) & 15, mb = (piece >> 10) & 15, g = piece >> 14;
    const int m = lane & 31, j = 2 * mb + (m >> 4), h = m & 15, k0 = 16 * ks + 8 * (lane >> 5), dir = k0 >> 7, ri = (k0 >> 6) & 1, p0 = k0 & 63, pg = dir * NG + g;
    float v[8];
#pragma unroll
    for (int e = 0; e < 8; ++e) { const int p = p0 + e; const Disc d = disc(in[9], in[10], in[11], pg, p); float pr, pi; apow(d, dir ? (L - j) : (j + 1), pr, pi);
        const float cr = in[14][((size_t)pg * GH + h) * NP + p], ci = in[15][((size_t)pg * GH + h) * NP + p];
        v[e] = ri ? -(cr * pi + ci * pr) : (cr * pr - ci * pi); }
    v4u w; w.x = pk2(v[0], v[1]); w.y = pk2(v[2], v[3]); w.z = pk2(v[4], v[5]); w.w = pk2(v[6], v[7]); *(v4u*)(WCF + (size_t)piece * 8) = w;
}
__device__ __forceinline__ void build_kt(const float* const* in, unsigned short* KT, int item, int lane) {
    const int tau = item % 63, g = item / 63, h = lane >> 2, hq = (lane & 3) * 4, n = tau >= 31 ? tau - 31 : 31 - tau;
    float acc[4] = {0.f, 0.f, 0.f, 0.f};
    for (int dir = 0; dir < 2; ++dir) {
        if ((dir == 0 && tau < 31) || (dir == 1 && tau > 31)) continue;
        const int pg = dir * NG + g;
        for (int p = 0; p < NP; ++p) { const Disc d = disc(in[9], in[10], in[11], pg, p); float pr, pi; apow(d, n, pr, pi);
            const float cr = in[14][((size_t)pg * GH + h) * NP + p], ci = in[15][((size_t)pg * GH + h) * NP + p];
            const float gr = cr * pr - ci * pi, gi = cr * pi + ci * pr;
            const float hr = gr * d.cre - gi * d.cim, hi_ = gr * d.cim + gi * d.cre;
            const float* br = in[12] + ((size_t)pg * NP + p) * GH + hq; const float* bi = in[13] + ((size_t)pg * NP + p) * GH + hq;
#pragma unroll
            for (int q = 0; q < 4; ++q) acc[q] += hr * br[q] - hi_ * bi[q]; }
    }
    const int half = hq >> 3; unsigned short* dst = KT + (size_t)g * KT_G + tau * 256 + h * 16 + ((half ^ (tau & 1)) * 8) + (hq & 7);
    *(unsigned long long*)dst = (unsigned long long)pk2(acc[0], acc[1]) | ((unsigned long long)pk2(acc[2], acc[3]) << 32);
}

__device__ __forceinline__ void ssm_unit(int b, int g, const float* const* in, const unsigned short* __restrict__ Ub, const unsigned short* __restrict__ WAF, const unsigned short* __restrict__ WCF,
                                         const unsigned short* __restrict__ KT, unsigned short* __restrict__ Y, LAS unsigned char* lds) {
    const int tid = threadIdx.x, wid = __builtin_amdgcn_readfirstlane(tid >> 6), lane = tid & 63, l31 = lane & 31, hi = lane >> 5;
    LAS unsigned char* U_l = lds + U_OFF; LAS float* S_l = (LAS float*)(lds + S_OFF); LAS unsigned char* KT_l = lds + KT_OFF; LAS unsigned char* X_l = lds + X_OFF;
#pragma unroll
    for (int it = 0; it < 8; ++it) { const int q = it * 512 + tid, tok = q >> 1, half = q & 1;
        const v4u w = *(const v4u*)(Ub + ((size_t)(b * SEQ + tok) * SSMW + g * GH + half * 8));
        *(LAS v4u*)(U_l + (tok >> 5) * U_CH + (tok & 31) * 32 + half * 16) = w; }
    LDS_WAIT(); __syncthreads();
    f32x16 sa0 = {}, sa1 = {};
    { const unsigned short* wa = WAF + (size_t)g * WAF_G + (size_t)wid * 32 * 512 + lane * 8; const LAS unsigned char* ub = U_l + l31 * U_CH + hi * 16;
#pragma unroll 8
      for (int i = 0; i < 32; ++i) { const bf16x8 a = *(const bf16x8*)(wa + i * 512);
          const bf16x8 b0 = *(const LAS bf16x8*)(ub + i * 32), b1 = *(const LAS bf16x8*)(ub + 32 * U_CH + i * 32);
          sa0 = __builtin_amdgcn_mfma_f32_32x32x16_bf16(a, b0, sa0, 0, 0, 0); sa1 = __builtin_amdgcn_mfma_f32_32x32x16_bf16(a, b1, sa1, 0, 0, 0); } }
    for (int d = 0; d < 2; ++d) {
        if ((wid >> 2) == d) {
#pragma unroll
            for (int r = 0; r < 16; ++r) { const int kk = 32 * (wid & 3) + (r & 3) + 8 * (r >> 2) + 4 * hi; S_l[kk * S_LD + l31] = sa0[r]; S_l[kk * S_LD + 32 + l31] = sa1[r]; } }
        LDS_WAIT(); __syncthreads();
        if (wid == 0) { const int p = lane; const Disc dd = disc(in[9], in[10], in[11], d * NG + g, p); float ar, ai; apow(dd, L, ar, ai);
            float xr = 0.f, xi = 0.f;
#pragma unroll 4
            for (int s = 0; s < NC; ++s) { const int c = d ? (NC - 1 - s) : s;
                LAS unsigned short* xp = (LAS unsigned short*)(X_l + c * X_CH) + d * 128 + p; xp[0] = (unsigned short)f2bf(xr); xp[64] = (unsigned short)f2bf(xi);
                const float sr = S_l[p * S_LD + c], si = S_l[(64 + p) * S_LD + c];
                const float nr = ar * xr - ai * xi + sr, ni = ar * xi + ai * xr + si; xr = nr; xi = ni; } }
        LDS_WAIT(); __syncthreads();
    }
#pragma unroll
    for (int it = 0; it < 4; ++it) { const int q = it * 512 + tid; if (q < 2016) *(LAS v4u*)(KT_l + q * 16) = *(const v4u*)(KT + (size_t)g * KT_G + q * 8); }
    LDS_WAIT(); __syncthreads();
    f32x16 acc[2][2] = {};
    { const unsigned short* wc0 = WCF + (size_t)g * WCF_G + (size_t)(2 * wid) * 16 * 512 + lane * 8; const LAS unsigned char* xb = X_l + l31 * X_CH + hi * 16;
#pragma unroll 4
      for (int ks = 0; ks < 16; ++ks) { const bf16x8 a0 = *(const bf16x8*)(wc0 + ks * 512), a1 = *(const bf16x8*)(wc0 + 16 * 512 + ks * 512);
          const bf16x8 b0 = *(const LAS bf16x8*)(xb + ks * 32), b1 = *(const LAS bf16x8*)(xb + 32 * X_CH + ks * 32);
          acc[0][0] = __builtin_amdgcn_mfma_f32_32x32x16_bf16(a0, b0, acc[0][0], 0, 0, 0); acc[0][1] = __builtin_amdgcn_mfma_f32_32x32x16_bf16(a0, b1, acc[0][1], 0, 0, 0);
          acc[1][0] = __builtin_amdgcn_mfma_f32_32x32x16_bf16(a1, b0, acc[1][0], 0, 0, 0); acc[1][1] = __builtin_amdgcn_mfma_f32_32x32x16_bf16(a1, b1, acc[1][1], 0, 0, 0); } }
    { const LAS unsigned char* ub = U_l + l31 * U_CH + hi * 16; const int jj = l31 >> 4, hrow = (l31 & 15) * 32;
#pragma unroll 4
      for (int i = 0; i < 32; ++i) { const bf16x8 b0 = *(const LAS bf16x8*)(ub + i * 32), b1 = *(const LAS bf16x8*)(ub + 32 * U_CH + i * 32);
          const int t0 = 4 * wid + jj - i + 31, t1 = t0 + 2;
          const bf16x8 a0 = *(const LAS bf16x8*)(KT_l + t0 * 512 + hrow + ((hi ^ (t0 & 1)) * 16)), a1 = *(const LAS bf16x8*)(KT_l + t1 * 512 + hrow + ((hi ^ (t1 & 1)) * 16));
          acc[0][0] = __builtin_amdgcn_mfma_f32_32x32x16_bf16(a0, b0, acc[0][0], 0, 0, 0); acc[0][1] = __builtin_amdgcn_mfma_f32_32x32x16_bf16(a0, b1, acc[0][1], 0, 0, 0);
          acc[1][0] = __builtin_amdgcn_mfma_f32_32x32x16_bf16(a1, b0, acc[1][0], 0, 0, 0); acc[1][1] = __builtin_amdgcn_mfma_f32_32x32x16_bf16(a1, b1, acc[1][1], 0, 0, 0); } }
    { const float* dsk = in[16] + g * GH;
#pragma unroll
      for (int mbi = 0; mbi < 2; ++mbi)
#pragma unroll
        for (int nb = 0; nb < 2; ++nb)
#pragma unroll
          for (int rq = 0; rq < 4; ++rq) { const int jj = rq >> 1, h0 = (rq & 1) * 8 + 4 * hi, n = 32 * nb + l31, j = 2 * (2 * wid + mbi) + jj, t = 32 * n + j;
              const unsigned long long uw = *(const LAS unsigned long long*)(U_l + n * U_CH + j * 32 + h0 * 2);
              const float u0 = bflo((unsigned)uw), u1 = bfhi((unsigned)uw), u2 = bflo((unsigned)(uw >> 32)), u3 = bfhi((unsigned)(uw >> 32));
              const float y0 = gelu_tanh(acc[mbi][nb][4 * rq + 0] + dsk[h0 + 0] * u0), y1 = gelu_tanh(acc[mbi][nb][4 * rq + 1] + dsk[h0 + 1] * u1);
              const float y2 = gelu_tanh(acc[mbi][nb][4 * rq + 2] + dsk[h0 + 2] * u2), y3 = gelu_tanh(acc[mbi][nb][4 * rq + 3] + dsk[h0 + 3] * u3);
              *(unsigned long long*)(Y + ((size_t)(b * SEQ + t) * SSMW + g * GH + h0)) = (unsigned long long)pk2(y0, y1) | ((unsigned long long)pk2(y2, y3) << 32); } }
    __syncthreads();
}
}
__device__ __forceinline__ void p0_ssm_tables(Frame& F) {
    unsigned short* WAF = (unsigned short*)(F.ws + WS_SSMT); unsigned short* WCF = WAF + (size_t)NG * ssm::WAF_G; unsigned short* KT = WCF + (size_t)NG * ssm::WCF_G;
    const int gt = F.vcu * 512 + F.tid, gs = F.G * 512;
    for (int piece = gt; piece < NG * 8 * 32 * 64; piece += gs) ssm::build_waf(F.in, WAF, piece);
    for (int piece = gt; piece < NG * 16 * 16 * 64; piece += gs) ssm::build_wcf(F.in, WCF, piece);
    const int gw = F.vcu * NWAVES + F.wave, NGW = F.G * NWAVES;
    for (int item = gw; item < NG * 63; item += NGW) ssm::build_kt(F.in, KT, item, F.lane);
}
#ifndef MK_N_LAUNCHES
#define MK_N_LAUNCHES 1
#endif
constexpr int N_PHASES = 9;
struct Args { const float* in[23]; float* out; unsigned char* ws; int ph_lo, ph_hi; };
__global__ void __launch_bounds__(NWAVES * 64, 2) fwd_kernel(Args args) {
    extern __shared__ __attribute__((aligned(16))) unsigned char lds[];
    Frame F;
    F.lds = (LAS unsigned char*)lds;
    F.MISC = (volatile LAS unsigned*)(F.lds + MISC_OFF);
    F.tid = threadIdx.x; F.lane = F.tid & 63; F.wave = __builtin_amdgcn_readfirstlane(F.tid >> 6);
    F.G = gridDim.x; { const int bx = blockIdx.x; F.vcu = (F.G % 8 == 0) ? (bx % 8) * (F.G / 8) + bx / 8 : bx; }
    F.ws = args.ws; F.out = args.out; F.ctl = (gu32*)(args.ws + WS_CTL);
#pragma unroll
    for (int i = 0; i < 23; ++i) F.in[i] = args.in[i];
    for (int u = F.tid; u < (LDS_BYTES - LDSCTL_OFF) / 4; u += NWAVES * 64) ((LAS unsigned*)(F.lds + LDSCTL_OFF))[u] = 0u;
    __syncthreads();
    const int lo = args.ph_lo, hi = args.ph_hi;
    const bool multi = (hi - lo) > 1;
    XcdBarrier bar; bar.bar = (unsigned*)(F.ctl + CW_BAR); bar.x = 0; bar.st = nullptr;
    if (multi) bar = xcd_barrier_post((unsigned*)(F.ctl + CW_BAR), F.MISC + 8);
#define IN(k) (lo <= (k) && (k) < hi)
#define SEAM(k) do { if (IN(k) && IN((k) + 1)) xcd_barrier(bar); } while (0)
    bf16* ws16 = (bf16*)args.ws;
    if (IN(0)) { p0_prologue(F); p0_ssm_tables(F); SEAM(0); }
    if (IN(1)) { p1a_norm(F); SEAM(1); }
    if (IN(2)) {
        pg8::Gemm g{ws16 + WS_H / 2, ws16 + WS_WIN / 2, M, NPROJ, DM}; pg8::StaticOrder S; S.init(M, NPROJ, F.G, (int)blockIdx.x);
        pg8::EpiProj E{ws16 + WS_QKV / 2, ws16 + WS_ZA / 2, ws16 + WS_U / 2, ws16 + WS_ZS / 2, ws16 + WS_GA / 2, ws16 + WS_GS / 2, (const float*)(args.ws + WS_ROPE), QSCALE};
        pg8::gemm_phase<pg8::EpiProj, pg8::StaticOrder, true, true>(F.lds + RING_OFF, g, S, E);
        SEAM(2); }
    if (IN(3)) {
#ifdef NAIVE_ATTN
        for (int u = F.vcu; u < NB * NH * 32; u += F.G) attn_naive_unit(F, u);
#else
        { float lam; { const float* lq = F.in[7]; float d1 = 0.f, d2 = 0.f; for (int i = 0; i < 64; ++i) { d1 += lq[i] * lq[64 + i]; d2 += lq[128 + i] * lq[192 + i]; } lam = __expf(d1) - __expf(d2) + LAM_INIT; }
          for (int u = F.vcu; u < NB * NH * 16; u += F.G) { const int bh = u >> 4, qb = u & 15;
              att::attn_unit(bh >> 2, bh & 3, qb, ws16 + WS_QKV / 2, ws16 + WS_ZA / 2, ws16 + WS_AIN / 2, F.in[8], lam, (char*)lds + RING_OFF); } }
#endif
#ifdef NAIVE_SSM
        { const int gw = F.vcu * NWAVES + F.wave; if ((gw & 3) == 0 && (gw >> 2) < NB * NG) ssm_naive_unit(F, gw >> 2); }
#else
        { const unsigned short* WAF = (const unsigned short*)(F.ws + WS_SSMT); const unsigned short* WCF = WAF + (size_t)NG * ssm::WAF_G; const unsigned short* KT = WCF + (size_t)NG * ssm::WCF_G;
          for (int u = F.vcu; u < NB * NG; u += F.G) { const int g = (u >> 3) & 31, b = (u & 7) + 8 * (u >> 8);
              ssm::ssm_unit(b, g, F.in, ws16 + WS_U / 2, WAF, WCF, KT, ws16 + WS_Y / 2, F.lds + RING_OFF); } }
#endif
        SEAM(3); }
    if (IN(4)) {
        pg8::Gemm g{ws16 + WS_Y / 2, ws16 + WS_WGLU / 2, M, 512, 512}; pg8::StaticOrder S; S.init(M, 512, F.G, (int)blockIdx.x);
        pg8::EpiGlu E{ws16 + WS_Y / 2, ws16 + WS_ZS / 2, ws16 + WS_Y2 / 2, F.in[18]};
        pg8::gemm_phase<pg8::EpiGlu, pg8::StaticOrder, true, true>(F.lds + RING_OFF, g, S, E);
        SEAM(4); }
    if (IN(5)) {
        pg8::Gemm g{ws16 + WS_AIN / 2, ws16 + WS_WUPA / 2, M, DM, 512}; pg8::StaticOrder S; S.init(M, DM, F.G, (int)blockIdx.x);
        pg8::EpiMerge<0> E{ws16 + WS_GA / 2, nullptr};
        pg8::gemm_phase<pg8::EpiMerge<0>, pg8::StaticOrder, true, true>(F.lds + RING_OFF, g, S, E);
        SEAM(5); }
    if (IN(6)) {
        pg8::Gemm g{ws16 + WS_Y2 / 2, ws16 + WS_WUPS / 2, M, DM, 512}; pg8::StaticOrder S; S.init(M, DM, F.G, (int)blockIdx.x);
        pg8::EpiMerge<1> E{ws16 + WS_GA / 2, ws16 + WS_GS / 2};
        pg8::gemm_phase<pg8::EpiMerge<1>, pg8::StaticOrder, true, true>(F.lds + RING_OFF, g, S, E);
        SEAM(6); }
    if (IN(7)) {
        pg8::Gemm g{ws16 + WS_GA / 2, ws16 + WS_WOUT / 2, M, DM, DM}; pg8::StaticOrder S; S.init(M, DM, F.G, (int)blockIdx.x);
        pg8::EpiOut E{F.in[0], (const float*)(args.ws + WS_GATE), F.out, (float*)(F.ctl + CW_ROWSS)};
        pg8::gemm_phase<pg8::EpiOut, pg8::StaticOrder, true, true>(F.lds + RING_OFF, g, S, E);
        SEAM(7); }
    if (IN(8)) { p6_final_norm(F); }
#undef IN
#undef SEAM
}

extern "C" void kernel_launch(void* const* d_in, const int* in_sizes, int n_in, void* d_out, int out_size, void* d_ws, size_t ws_size, hipStream_t stream) {
    static int grid = 0;
    if (grid == 0) {
        if (n_in != 23 || in_sizes[0] != M * DM || out_size != M * DM || ws_size < WS_END) { fprintf(stderr, "kernel_launch: shape/workspace mismatch (n_in %d, in0 %d, out %d, ws %zu)\n", n_in, n_in > 0 ? in_sizes[0] : -1, out_size, ws_size); grid = -1; return; }
        if (hipFuncSetAttribute((const void*)fwd_kernel, hipFuncAttributeMaxDynamicSharedMemorySize, LDS_BYTES) != hipSuccess) { fprintf(stderr, "kernel_launch: hipFuncSetAttribute failed\n"); grid = -1; return; }
        int per_cu = 0;
        if (hipOccupancyMaxActiveBlocksPerMultiprocessor(&per_cu, (const void*)fwd_kernel, NWAVES * 64, LDS_BYTES) != hipSuccess || per_cu < 1) fprintf(stderr, "kernel_launch: occupancy query reports %d\n", per_cu);
        (void)hipGetLastError();
        grid = 256;
    }
    if (grid < 0) return;
    if (hipMemsetAsync((char*)d_ws + WS_CTL, 0, CTL_ZERO_BYTES, stream) != hipSuccess) { fprintf(stderr, "kernel_launch: memset failed\n"); return; }
    Args a{};
    for (int i = 0; i < 23; ++i) a.in[i] = (const float*)d_in[i];
    a.out = (float*)d_out; a.ws = (unsigned char*)d_ws;
    if (MK_N_LAUNCHES == 1) { a.ph_lo = 0; a.ph_hi = N_PHASES; hipLaunchKernelGGL(fwd_kernel, dim3(grid), dim3(NWAVES * 64), LDS_BYTES, stream, a); }
    else for (int p = 0; p < N_PHASES; ++p) { a.ph_lo = p; a.ph_hi = p + 1; hipLaunchKernelGGL(fwd_kernel, dim3(grid), dim3(NWAVES * 64), LDS_BYTES, stream, a); }
    const hipError_t le = hipPeekAtLastError();
    if (le != hipSuccess) fprintf(stderr, "kernel_launch: launch failed: %s\n", hipGetErrorName(le));
}
```

```cpp
#include <hip/hip_runtime.h>
#include <cstdio>
#include <cstdint>
namespace pg8 {
#define PG8_LAS __attribute__((address_space(3)))
typedef unsigned short bf16_t;
typedef short bf16x8 __attribute__((ext_vector_type(8)));
typedef float f32x4 __attribute__((ext_vector_type(4)));
typedef unsigned u32x4 __attribute__((ext_vector_type(4)));
constexpr int BM = 256, BK = 64, HALF = 128, HTB = HALF * BK * 2  , STAGE_BYTES = 8 * HTB, NXCD = 8, WGM = 8;

__host__ __device__ __forceinline__ int lds_byte(int r, int c) { const int st = (r >> 4) * 2 + (c >> 5), rr = r & 15, cc = c & 31, ob = rr * 64 + cc * 2; return st * 1024 + (ob ^ (((ob >> 9) & 1) << 5)); }
__host__ __device__ __forceinline__ void stage_rc(int b, int& R, int& C) { const int st = b / 1024, sb = b % 1024, swz = sb ^ (((sb >> 9) & 1) << 5); R = (st >> 1) * 16 + swz / 64; C = (st & 1) * 32 + (swz % 64) / 2; }
__host__ __device__ __forceinline__ int perm32(int rho) { const int n = rho >> 4, i = rho & 15; return 8 * (i >> 2) + 4 * n + (i & 3); }

struct Unit { int pm, pn; };
struct Gemm { const bf16_t* A; const bf16_t* Bt; int M, N, K; };

struct StaticOrder {
    int nM, nN, nwg, G, c;
    __host__ __device__ void init(int M, int N, int G_, int c_) { nM = M / BM; nN = N / BM; nwg = nM * nN; G = G_; c = c_; }
    __host__ __device__ bool next(int i, Unit& u) const {
        const long L = (long)i * G + c; if (L >= nwg) return false;
        int wgid = (int)L; { const int q = nwg / NXCD, r = nwg % NXCD, xcd = wgid % NXCD, off = wgid / NXCD; wgid = (xcd < r ? xcd * (q + 1) : r * (q + 1) + (xcd - r) * q) + off; }
        const int nig = WGM * nN, gid = wgid / nig, fm = gid * WGM, gsz = (nM - fm) < WGM ? (nM - fm) : WGM;
        u.pm = fm + ((wgid % nig) % gsz); u.pn = (wgid % nig) / gsz; return true;
    }
    __device__ __forceinline__ void a_ready(const Unit&) const {}
    __device__ __forceinline__ void done(const Unit&) const {}
};

__device__ __forceinline__ unsigned cvt_pk_bf16(float lo, float hi) { unsigned r; asm volatile("v_cvt_pk_bf16_f32 %0, %1, %2" : "=v"(r) : "v"(lo), "v"(hi)); return r; }
__device__ __forceinline__ float bf_lo(unsigned w) { return __uint_as_float(w << 16); }
__device__ __forceinline__ float bf_hi(unsigned w) { return __uint_as_float(w & 0xffff0000u); }
__device__ __forceinline__ float sigmoid_f(float x) { return __builtin_amdgcn_rcpf(1.0f + __builtin_amdgcn_exp2f(-1.4426950408889634f * x)); }
__device__ __forceinline__ void unpack8(const u32x4 w, float (&f)[8]) { f[0] = bf_lo(w.x); f[1] = bf_hi(w.x); f[2] = bf_lo(w.y); f[3] = bf_hi(w.y); f[4] = bf_lo(w.z); f[5] = bf_hi(w.z); f[6] = bf_lo(w.w); f[7] = bf_hi(w.w); }
__device__ __forceinline__ u32x4 pack8(const float (&f)[8]) { u32x4 w; w.x = cvt_pk_bf16(f[0], f[1]); w.y = cvt_pk_bf16(f[2], f[3]); w.z = cvt_pk_bf16(f[4], f[5]); w.w = cvt_pk_bf16(f[6], f[7]); return w; }

struct EpiProj {
    static constexpr bool PERM = true, AFTER_DRAIN = false;
    bf16_t *QKV, *ZA, *U, *ZS, *GA, *GS; const float* rope; float qscale;
    __device__ __forceinline__ void operator()(const f32x4 (&acc)[2][2][4][2], const Unit& u, int wr, int wc, int fr, int fq) const {
        const int pn = u.pn; bf16_t* base; int ldc, colt, act;
        float sc = 1.f;
        if (pn < 2)       { base = QKV; ldc = 1536; colt = pn * 256; act = 3; sc = qscale; }
        else if (pn < 4)  { base = QKV; ldc = 1536; colt = 512 + (pn - 2) * 256; act = 3; }
        else if (pn < 6)  { base = QKV; ldc = 1536; colt = 1024 + (pn - 4) * 256; act = 0; }
        else if (pn < 8)  { base = ZA; ldc = 512; colt = (pn - 6) * 256; act = 1; }
        else if (pn < 10) { base = U;  ldc = 512; colt = (pn - 8) * 256; act = 0; }
        else if (pn < 12) { base = ZS; ldc = 512; colt = (pn - 10) * 256; act = 1; }
        else if (pn < 16) { base = GA; ldc = 1024; colt = (pn - 12) * 256; act = 2; }
        else              { base = GS; ldc = 1024; colt = (pn - 16) * 256; act = 2; }
        const int row0 = u.pm * BM + wr * 64 + fr, col0 = colt + wc * 32 + 8 * fq;
        const bool rotw = (act == 3) && ((wc & 1) == 0);
#pragma unroll
        for (int ai = 0; ai < 2; ++ai)
#pragma unroll
            for (int m = 0; m < 4; ++m) {
                const int row = row0 + ai * HALF + m * 16; bf16_t* rowp = base + (size_t)row * ldc + col0;
                float cs[8], sn[8];
                if (rotw) { const f32x4* rp = (const f32x4*)(rope + (size_t)row * 16); const f32x4 c0 = rp[0], c1 = rp[1], s0 = rp[2], s1 = rp[3];
                    cs[0] = c0[0]; cs[1] = c0[1]; cs[2] = c0[2]; cs[3] = c0[3]; cs[4] = c1[0]; cs[5] = c1[1]; cs[6] = c1[2]; cs[7] = c1[3];
                    sn[0] = s0[0]; sn[1] = s0[1]; sn[2] = s0[2]; sn[3] = s0[3]; sn[4] = s1[0]; sn[5] = s1[1]; sn[6] = s1[2]; sn[7] = s1[3]; }
#pragma unroll
                for (int bj = 0; bj < 2; ++bj) {
                    float v[8];
#pragma unroll
                    for (int e = 0; e < 4; ++e) { v[e] = acc[ai][bj][m][0][e]; v[4 + e] = acc[ai][bj][m][1][e]; }
                    if (act == 1) {
#pragma unroll
                        for (int e = 0; e < 8; ++e) v[e] = v[e] * sigmoid_f(v[e]);
                    } else if (act == 2) {
#pragma unroll
                        for (int e = 0; e < 8; ++e) v[e] = sigmoid_f(v[e]);
                    } else if (act == 3) {
                        if (rotw) {
#pragma unroll
                            for (int e = 0; e < 8; ++e) { const float o = __shfl_xor(v[e], 16);
                                const float r1 = v[e] * cs[e] - o * sn[e], r2 = v[e] * cs[e] + o * sn[e];
                                v[e] = (fq == 0) ? r1 : ((fq == 1) ? r2 : v[e]); }
                        }
#pragma unroll
                        for (int e = 0; e < 8; ++e) v[e] *= sc;
                    }
                    *(u32x4*)(rowp + bj * HALF) = pack8(v);
                }
            }
    }
};
struct EpiGlu {
    static constexpr bool PERM = true, AFTER_DRAIN = false;
    const bf16_t *Y, *ZS; bf16_t* Y2; const float* bias;
    __device__ __forceinline__ void operator()(const f32x4 (&acc)[2][2][4][2], const Unit& u, int wr, int wc, int fr, int fq) const {
        const int row0 = u.pm * BM + wr * 64 + fr, col0 = u.pn * BM + wc * 32 + 8 * fq;
#pragma unroll
        for (int ai = 0; ai < 2; ++ai)
#pragma unroll
            for (int m = 0; m < 4; ++m) { const size_t off = (size_t)(row0 + ai * HALF + m * 16) * 512 + col0;
#pragma unroll
                for (int bj = 0; bj < 2; ++bj) {
                    const f32x4 b0 = *(const f32x4*)(bias + col0 + bj * HALF), b1 = *(const f32x4*)(bias + col0 + bj * HALF + 4);
                    float yv[8], zv[8], v[8]; unpack8(*(const u32x4*)(Y + off + bj * HALF), yv); unpack8(*(const u32x4*)(ZS + off + bj * HALF), zv);
#pragma unroll
                    for (int e = 0; e < 4; ++e) { v[e] = yv[e] * sigmoid_f(acc[ai][bj][m][0][e] + b0[e]) * zv[e]; v[4 + e] = yv[4 + e] * sigmoid_f(acc[ai][bj][m][1][e] + b1[e]) * zv[4 + e]; }
                    *(u32x4*)(Y2 + off + bj * HALF) = pack8(v);
                } }
    }
};
template <int MODE> struct EpiMerge {
    static constexpr bool PERM = true, AFTER_DRAIN = false;
    bf16_t* G; const bf16_t* G2;
    __device__ __forceinline__ void operator()(const f32x4 (&acc)[2][2][4][2], const Unit& u, int wr, int wc, int fr, int fq) const {
        const int row0 = u.pm * BM + wr * 64 + fr, col0 = u.pn * BM + wc * 32 + 8 * fq;
#pragma unroll
        for (int ai = 0; ai < 2; ++ai)
#pragma unroll
            for (int m = 0; m < 4; ++m) { const size_t off = (size_t)(row0 + ai * HALF + m * 16) * 1024 + col0;
#pragma unroll
                for (int bj = 0; bj < 2; ++bj) {
                    float g[8], v[8]; unpack8(*(const u32x4*)(G + off + bj * HALF), g);
                    if (MODE == 0) {
#pragma unroll
                        for (int e = 0; e < 4; ++e) { v[e] = g[e] * acc[ai][bj][m][0][e]; v[4 + e] = g[4 + e] * acc[ai][bj][m][1][e]; }
                    } else { float g2[8]; unpack8(*(const u32x4*)(G2 + off + bj * HALF), g2);
#pragma unroll
                        for (int e = 0; e < 4; ++e) { v[e] = g[e] + g2[e] * acc[ai][bj][m][0][e]; v[4 + e] = g[4 + e] + g2[4 + e] * acc[ai][bj][m][1][e]; }
                    }
                    *(u32x4*)(G + off + bj * HALF) = pack8(v);
                } }
    }
};
struct EpiOut {
    static constexpr bool PERM = true, AFTER_DRAIN = false;
    const float* x; const float* gate; float* out; float* rowss;
    __device__ __forceinline__ void operator()(const f32x4 (&acc)[2][2][4][2], const Unit& u, int wr, int wc, int fr, int fq) const {
        const int row0 = u.pm * BM + wr * 64 + fr, col0 = u.pn * BM + wc * 32 + 8 * fq;
        const float* gb = gate + (size_t)((u.pm * BM) >> 11) * 1024;
        f32x4 g[2][2];
#pragma unroll
        for (int bj = 0; bj < 2; ++bj) { g[bj][0] = *(const f32x4*)(gb + col0 + bj * HALF); g[bj][1] = *(const f32x4*)(gb + col0 + bj * HALF + 4); }
#pragma unroll
        for (int ai = 0; ai < 2; ++ai)
#pragma unroll
            for (int m = 0; m < 4; ++m) { const int row = row0 + ai * HALF + m * 16; const size_t off = (size_t)row * 1024 + col0; float ss = 0.f;
#pragma unroll
                for (int bj = 0; bj < 2; ++bj)
#pragma unroll
                    for (int n = 0; n < 2; ++n) { const f32x4 xv = *(const f32x4*)(x + off + bj * HALF + 4 * n); const f32x4 o = xv + g[bj][n] * acc[ai][bj][m][n];
                        *(f32x4*)(out + off + bj * HALF + 4 * n) = o; ss += (o[0] * o[0] + o[1] * o[1]) + (o[2] * o[2] + o[3] * o[3]); }
                ss += __shfl_xor(ss, 16); ss += __shfl_xor(ss, 32);
                if (fq == 0) atomicAdd(rowss + row, ss); }
    }
};

template <class Epi, class Sched, bool ALIGN_EPI = false, bool SP2 = false>
__device__ __forceinline__ void gemm_phase(PG8_LAS unsigned char* lds, const Gemm g, const Sched& S, const Epi& E) {
    const int tid = threadIdx.x, wid = __builtin_amdgcn_readfirstlane(tid >> 6), lane = tid & 63, wr = wid >> 2, wc = wid & 3, fr = lane & 15, fq = lane >> 4;
    const int K = g.K, nt = K / BK;
    unsigned voffA[2], voffB[2];
#pragma unroll
    for (int i = 0; i < 2; ++i) { int R, C; stage_rc(tid * 16 + i * 8192, R, C); const int Rb = Epi::PERM ? ((R & ~31) + perm32(R & 31)) : R;
        voffA[i] = (unsigned)(R * K + C) * 2u; voffB[i] = (unsigned)(Rb * K + C) * 2u; }
    const size_t kstep = (size_t)(BK * 2);
    const size_t hstep = (size_t)HALF * K * 2;
    const size_t tstep = 2 * hstep;
    const unsigned ldsw = (unsigned)wid * 1024u;
    const int aoff = lds_byte(wr * 64 + fr, fq * 8), boff = lds_byte(wc * 32 + fr, fq * 8);
#define PG8_SA(b, h) (((b) * 2 + (h)) * HTB)
#define PG8_SB(b, h) ((4 + (b) * 2 + (h)) * HTB)
#define PG8_STAGE(bufoff, gbase, voff) do { _Pragma("unroll") for (int _i = 0; _i < 2; ++_i) \
        __builtin_amdgcn_global_load_lds((const unsigned*)((const char*)(gbase) + (voff)[_i]), (PG8_LAS unsigned*)(lds + (bufoff) + ldsw + _i * 8192), 16, 0, 0); } while (0)
#define PG8_LDA(dst, b, h) do { _Pragma("unroll") for (int m = 0; m < 4; ++m) _Pragma("unroll") for (int k = 0; k < 2; ++k) dst[m][k] = *(const PG8_LAS bf16x8*)(lds + PG8_SA(b, h) + aoff + m * 2048 + k * 1024); } while (0)
#define PG8_LDB(dst, b, h) do { _Pragma("unroll") for (int n = 0; n < 2; ++n) _Pragma("unroll") for (int k = 0; k < 2; ++k) dst[n][k] = *(const PG8_LAS bf16x8*)(lds + PG8_SB(b, h) + boff + n * 2048 + k * 1024); } while (0)
#define PG8_MMA(ai, bj, At, Bt) do { __builtin_amdgcn_s_setprio(1); _Pragma("unroll") for (int m = 0; m < 4; ++m) _Pragma("unroll") for (int n = 0; n < 2; ++n) _Pragma("unroll") for (int k = 0; k < 2; ++k) \
        acc[ai][bj][m][n] = __builtin_amdgcn_mfma_f32_16x16x32_bf16(Bt[n][k], At[m][k], acc[ai][bj][m][n], 0, 0, 0); __builtin_amdgcn_s_setprio(0); } while (0)
#define PG8_WAIT_V(n) asm volatile("s_waitcnt vmcnt(" #n ")" ::: "memory")
#define PG8_WAIT_L(n) asm volatile("s_waitcnt lgkmcnt(" #n ")" ::: "memory")
#define PG8_BAR __builtin_amdgcn_s_barrier()
#define PG8_SCHED __builtin_amdgcn_sched_barrier(0)
    Unit cur, nxt; int ui = 0;
    if (!S.next(0, cur)) return;
    f32x4 acc[2][2][4][2];
#pragma unroll
    for (int a = 0; a < 2; ++a)
#pragma unroll
        for (int b = 0; b < 2; ++b)
#pragma unroll
            for (int m = 0; m < 4; ++m)
#pragma unroll
                for (int n = 0; n < 2; ++n) acc[a][b][m][n] = (f32x4){0.f, 0.f, 0.f, 0.f};
    bf16x8 At[4][2], B0[2][2], B1[2][2];
    const char* cA = (const char*)g.A + (size_t)cur.pm * tstep; const char* cB = (const char*)g.Bt + (size_t)cur.pn * tstep;
    S.a_ready(cur);
    if constexpr (SP2) {
        PG8_STAGE(PG8_SB(0, 0), cB, voffB); PG8_STAGE(PG8_SB(0, 1), cB + hstep, voffB); PG8_STAGE(PG8_SA(0, 0), cA, voffA); PG8_STAGE(PG8_SA(0, 1), cA + hstep, voffA);
        if (wr == 1) PG8_BAR;
        PG8_WAIT_V(2); PG8_BAR;
        PG8_STAGE(PG8_SB(1, 0), cB + kstep, voffB); PG8_STAGE(PG8_SA(1, 0), cA + kstep, voffA); PG8_STAGE(PG8_SB(1, 1), cB + hstep + kstep, voffB);
        PG8_WAIT_V(6); PG8_BAR;
    } else {
        PG8_STAGE(PG8_SB(0, 0), cB, voffB); PG8_STAGE(PG8_SA(0, 0), cA, voffA); PG8_STAGE(PG8_SB(0, 1), cB + hstep, voffB); PG8_STAGE(PG8_SA(0, 1), cA + hstep, voffA);
        if (wr == 1) PG8_BAR;
        PG8_WAIT_V(4); PG8_BAR;
        PG8_STAGE(PG8_SB(1, 0), cB + kstep, voffB); PG8_STAGE(PG8_SA(1, 0), cA + kstep, voffA); PG8_STAGE(PG8_SB(1, 1), cB + hstep + kstep, voffB);
        PG8_WAIT_V(6); PG8_BAR;
    }
    for (;;) {
        const bool has_next = S.next(ui + 1, nxt);
        const char* nA = has_next ? (const char*)g.A + (size_t)nxt.pm * tstep : cA; const char* nB = has_next ? (const char*)g.Bt + (size_t)nxt.pn * tstep : cB;
        for (int t = 0; t < nt; t += 2) {
            const bool last = (t == nt - 2);
            const char* a1 = cA + (size_t)(t + 1) * kstep;
            const char* a2 = last ? nA : cA + (size_t)(t + 2) * kstep; const char* b2 = last ? nB : cB + (size_t)(t + 2) * kstep;
            const char* a3 = a2 + kstep; const char* b3 = b2 + kstep;
            if (last && has_next) S.a_ready(nxt);
            if constexpr (SP2) {
            PG8_LDB(B0, 0, 0); PG8_LDB(B1, 0, 1); PG8_SCHED; PG8_LDA(At, 0, 0); PG8_STAGE(PG8_SA(1, 1), a1 + hstep, voffA);
            PG8_WAIT_V(8); PG8_WAIT_L(0); PG8_BAR; PG8_MMA(0, 0, At, B0); PG8_MMA(0, 1, At, B1); PG8_BAR; PG8_SCHED;
            PG8_LDA(At, 0, 1); PG8_STAGE(PG8_SB(0, 0), b2, voffB); PG8_STAGE(PG8_SB(0, 1), b2 + hstep, voffB); PG8_STAGE(PG8_SA(0, 0), a2, voffA);
            PG8_WAIT_V(8); PG8_WAIT_L(0); PG8_BAR; PG8_MMA(1, 0, At, B0); PG8_MMA(1, 1, At, B1); PG8_BAR; PG8_SCHED;
            PG8_LDB(B0, 1, 0); PG8_LDB(B1, 1, 1); PG8_SCHED; PG8_LDA(At, 1, 0); PG8_STAGE(PG8_SA(0, 1), a2 + hstep, voffA);
            PG8_WAIT_V(8); PG8_WAIT_L(0); PG8_BAR; PG8_MMA(0, 0, At, B0); PG8_MMA(0, 1, At, B1); PG8_BAR; PG8_SCHED;
            PG8_LDA(At, 1, 1); PG8_STAGE(PG8_SB(1, 0), b3, voffB); PG8_STAGE(PG8_SB(1, 1), b3 + hstep, voffB); PG8_STAGE(PG8_SA(1, 0), a3, voffA);
            PG8_WAIT_V(8); PG8_WAIT_L(0); PG8_BAR; PG8_MMA(1, 0, At, B0); PG8_MMA(1, 1, At, B1); PG8_BAR; PG8_SCHED;
            } else {
            PG8_LDB(B0, 0, 0); PG8_SCHED; PG8_LDA(At, 0, 0); PG8_STAGE(PG8_SA(1, 1), a1 + hstep, voffA);
            PG8_WAIT_L(8); PG8_BAR; PG8_WAIT_L(0); PG8_MMA(0, 0, At, B0); PG8_BAR; PG8_SCHED;
            PG8_LDB(B1, 0, 1); PG8_STAGE(PG8_SB(0, 0), b2, voffB);
            PG8_BAR; PG8_WAIT_L(0); PG8_MMA(0, 1, At, B1); PG8_BAR;
            PG8_LDA(At, 0, 1); PG8_STAGE(PG8_SA(0, 0), a2, voffA);
            PG8_BAR; PG8_WAIT_L(0); PG8_MMA(1, 0, At, B0); PG8_BAR; PG8_SCHED;
            PG8_STAGE(PG8_SB(0, 1), b2 + hstep, voffB);
            PG8_WAIT_V(6); PG8_BAR; PG8_MMA(1, 1, At, B1); PG8_BAR;
            PG8_LDB(B0, 1, 0); PG8_SCHED; PG8_LDA(At, 1, 0); PG8_STAGE(PG8_SA(0, 1), a2 + hstep, voffA);
            PG8_WAIT_L(8); PG8_BAR; PG8_WAIT_L(0); PG8_MMA(0, 0, At, B0); PG8_BAR; PG8_SCHED;
            PG8_LDB(B1, 1, 1); PG8_STAGE(PG8_SB(1, 0), b3, voffB);
            PG8_BAR; PG8_WAIT_L(0); PG8_MMA(0, 1, At, B1); PG8_BAR;
            PG8_LDA(At, 1, 1); PG8_STAGE(PG8_SA(1, 0), a3, voffA);
            PG8_BAR; PG8_WAIT_L(0); PG8_MMA(1, 0, At, B0); PG8_BAR; PG8_SCHED;
            PG8_STAGE(PG8_SB(1, 1), b3 + hstep, voffB);
            PG8_WAIT_V(6); PG8_BAR; PG8_MMA(1, 1, At, B1); PG8_BAR;
            }
        }
        if constexpr (ALIGN_EPI) { if (wr == 0) PG8_BAR; }
        if constexpr (!Epi::AFTER_DRAIN) { E(acc, cur, wr, wc, fr, fq); S.done(cur); }
        if (!has_next) break;
#pragma unroll
        for (int a = 0; a < 2; ++a)
#pragma unroll
            for (int b = 0; b < 2; ++b)
#pragma unroll
                for (int m = 0; m < 4; ++m)
#pragma unroll
                    for (int n = 0; n < 2; ++n) acc[a][b][m][n] = (f32x4){0.f, 0.f, 0.f, 0.f};
        cur = nxt; cA = nA; cB = nB; ++ui;
        if constexpr (ALIGN_EPI) { if (wr == 1) PG8_BAR; }
    }
    PG8_WAIT_V(0);
    if constexpr (!ALIGN_EPI) { if (wr == 0) PG8_BAR; }
    PG8_BAR;
    if constexpr (Epi::AFTER_DRAIN) { E.fused(acc, cur, wr, wc, fr, fq, lds, wid, lane); S.done(cur); }
#undef PG8_SA
#undef PG8_SB
#undef PG8_STAGE
#undef PG8_LDA
#undef PG8_LDB
#undef PG8_MMA
#undef PG8_WAIT_V
#undef PG8_WAIT_L
#undef PG8_BAR
#undef PG8_SCHED
}
}
#define GAS __attribute__((address_space(1)))
#define LAS __attribute__((address_space(3)))
typedef unsigned short bf16;
typedef unsigned v4u __attribute__((ext_vector_type(4)));
typedef float f32x4 __attribute__((ext_vector_type(4)));
typedef short bf16x8 __attribute__((ext_vector_type(8)));
typedef GAS unsigned gu32;
typedef GAS unsigned long long gu64;
#define RLX_AGENT __ATOMIC_RELAXED, __HIP_MEMORY_SCOPE_AGENT
#define LDS_WAIT() asm volatile("s_waitcnt lgkmcnt(0)" ::: "memory")
#define VM_WAIT() asm volatile("s_waitcnt vmcnt(0)" ::: "memory")
__device__ __forceinline__ unsigned long long rt() { return __builtin_amdgcn_s_memrealtime(); }
__device__ __forceinline__ unsigned f2bf(float f) { unsigned u = __builtin_bit_cast(unsigned, f); return (u + 0x7fffu + ((u >> 16) & 1u)) >> 16; }
__device__ __forceinline__ unsigned pk2(float lo, float hi) { return f2bf(lo) | (f2bf(hi) << 16); }

#define XB_TMO      128
#define XB_XCNT(j)  (256  + 64 * (j))
#define XB_XSUB(j)  (1280 + 64 * (j))
#define XB_XGEN(j)  (2304 + 64 * (j))
#define XB_TOP      3328
#define XB_TOPGEN   3392
#define XCD_BAR_WORDS 3456
#define XB_SPIN_CAP (1u << 18)

__device__ __forceinline__ unsigned xb_ld(unsigned* p)              { return __hip_atomic_load(p, __ATOMIC_RELAXED, __HIP_MEMORY_SCOPE_AGENT); }
__device__ __forceinline__ unsigned xb_add(unsigned* p, unsigned v) { return __hip_atomic_fetch_add(p, v, __ATOMIC_RELAXED, __HIP_MEMORY_SCOPE_AGENT); }
__device__ __forceinline__ unsigned xb_xcc_id() { return (unsigned)__builtin_amdgcn_s_getreg((3 << 11) | 20) & 0xFu; }
#define XB_SPIN(cond, bar) do { unsigned _sp = 0; while (cond) { __builtin_amdgcn_s_sleep(1); \
    if ((++_sp & 255u) == 0u) { if (xb_ld(&(bar)[XB_TMO])) break; if (_sp > XB_SPIN_CAP) { atomicAdd(&(bar)[XB_TMO], 1u); break; } } } } while (0)

struct XcdBarrier {
    unsigned* bar; unsigned x;
    volatile LAS unsigned* st;
};

__device__ __forceinline__ XcdBarrier xcd_barrier_post(unsigned* bar, volatile LAS unsigned* st) {
    XcdBarrier b; b.bar = bar; b.x = xb_xcc_id(); b.st = st;
    if (threadIdx.x == 0) (void)xb_add(&bar[XB_XCNT(b.x)], 1u);
    return b;
}
__device__ __forceinline__ void xcd_barrier_complete(unsigned* bar, unsigned x, unsigned& nloc, unsigned& nx) {
    const unsigned G = gridDim.x * gridDim.y * gridDim.z;
    unsigned sum, cnt, mine, sp = 0u;
    for (;;) {
        sum = 0u; cnt = 0u; mine = 0u;
#pragma unroll
        for (unsigned j = 0; j < 16; ++j) { const unsigned c = xb_ld(&bar[XB_XCNT(j)]); sum += c; cnt += (c > 0u) ? 1u : 0u; mine = (j == x) ? c : mine; }
        if (sum == G) break;
        __builtin_amdgcn_s_sleep(1);
        if ((++sp & 255u) == 0u) { if (xb_ld(&bar[XB_TMO])) break; if (sp > XB_SPIN_CAP) { atomicAdd(&bar[XB_TMO], 1u); break; } }
    }
    nloc = mine > 0u ? mine : 1u; nx = cnt > 0u ? cnt : 1u;
}

__device__ __forceinline__ void xcd_barrier(const XcdBarrier& b) {
    asm volatile("s_waitcnt vmcnt(0)" ::: "memory");
    __syncthreads();
    if (threadIdx.x == 0) {
        unsigned* bar = b.bar;
        __builtin_amdgcn_s_waitcnt(0);
        unsigned nloc = b.st[0], nx = b.st[1];
        if (nloc == 0u) { xcd_barrier_complete(bar, b.x, nloc, nx); b.st[0] = nloc; b.st[1] = nx; }
        const unsigned old = xb_add(&bar[XB_XSUB(b.x)], 1u);
        const unsigned gen = old / nloc;
        if (old + 1u == (gen + 1u) * nloc) {
            __builtin_amdgcn_fence(__ATOMIC_RELEASE, "agent");
            asm volatile("s_waitcnt vmcnt(0)" ::: "memory");
            const unsigned og = xb_add(&bar[XB_TOP], 1u);
            const unsigned tg = og / nx;
            if (og + 1u == (tg + 1u) * nx) xb_add(&bar[XB_TOPGEN], 1u);
            else XB_SPIN(xb_ld(&bar[XB_TOPGEN]) == tg, bar);
            __builtin_amdgcn_fence(__ATOMIC_ACQUIRE, "agent");
            xb_add(&bar[XB_XGEN(b.x)], 1u);
            asm volatile("s_waitcnt vmcnt(0)" ::: "memory");
        } else {
            XB_SPIN(xb_ld(&bar[XB_XGEN(b.x)]) == gen, bar);
            __builtin_amdgcn_fence(__ATOMIC_ACQUIRE, "agent");
            asm volatile("s_waitcnt vmcnt(0)" ::: "memory");
        }
    }
    __syncthreads();
}
constexpr int NWAVES = 8;
constexpr int NB = 16, SEQ = 2048, DM = 1024, M = NB * SEQ;
constexpr int NPROJ = 5120, QKVW = 1536;
constexpr int NH = 4, HD = 64, VD = 128;
constexpr int SSMW = 512, NG = 32, GH = 16, NP = 64;
constexpr float EPS = 1e-6f, LOG2E = 1.4426950408889634f, QSCALE = 0.125f * LOG2E;
constexpr float LAM_INIT = 0.2f;
constexpr int KSL = 8;

constexpr size_t MiB = 1u << 20;
constexpr size_t WS_CTL = 0, CTL_ZERO_BYTES = 1 * MiB;
constexpr size_t WS_MODP = 1 * MiB;
constexpr size_t WS_GATE = 3 * MiB;
constexpr size_t WS_ROPE = 4 * MiB;
constexpr size_t WS_WIN = 6 * MiB, WS_WGLU = 16 * MiB, WS_WUPA = 17 * MiB, WS_WUPS = 18 * MiB, WS_WOUT = 19 * MiB;
constexpr size_t WS_SSMT = 22 * MiB;
constexpr size_t WS_H = 40 * MiB;
constexpr size_t WS_AIN = 40 * MiB, WS_Y = 72 * MiB;
constexpr size_t WS_QKV = 104 * MiB;
constexpr size_t WS_ZA = 200 * MiB, WS_U = 232 * MiB, WS_ZS = 264 * MiB;
constexpr size_t WS_Y2 = WS_U;
constexpr size_t WS_GA = 296 * MiB, WS_GS = 360 * MiB;
constexpr size_t WS_YTMP = 424 * MiB;
constexpr size_t WS_END = 488 * MiB;
constexpr int CW_TMO = 0, CW_BAR = 4096, CW_ROWSS = 65536;
static_assert((CW_ROWSS + M) * 4 <= (int)CTL_ZERO_BYTES, "ctl");

constexpr int RING_OFF = 0, RING_BYTES = 139264;
constexpr int LDSCTL_OFF = RING_BYTES, MISC_OFF = LDSCTL_OFF + 320;
constexpr int LDS_BYTES = RING_BYTES + 1024;
struct Frame {
    LAS unsigned char* lds;
    volatile LAS unsigned* MISC;
    gu32* ctl;
    int tid, lane, wave;
    int vcu, G;
    const float* in[23]; float* out; unsigned char* ws;
};
__device__ __forceinline__ float wave_sum(float v) {
#pragma unroll
    for (int o = 1; o < 64; o <<= 1) v += __shfl_xor(v, o);
    return v;
}
__device__ __forceinline__ float sigm(float x) { return __builtin_amdgcn_rcpf(1.0f + __builtin_amdgcn_exp2f(-LOG2E * x)); }
__device__ __forceinline__ float bflo(unsigned w) { return __uint_as_float(w << 16); }
__device__ __forceinline__ float bfhi(unsigned w) { return __uint_as_float(w & 0xffff0000u); }
__device__ __forceinline__ float sin_rev(float ang) { float r = ang * 0.15915494309189535f; r -= floorf(r); return __builtin_amdgcn_sinf(r); }
__device__ __forceinline__ float cos_rev(float ang) { float r = ang * 0.15915494309189535f; r -= floorf(r); return __builtin_amdgcn_cosf(r); }

__device__ __forceinline__ void p0_transpose_item(const float* W, int K, int N, bf16* WT, LAS float* scr, int item, int lane) {
    const int nblk = N / 32, kb = item / nblk, nb = item % nblk, k0 = 64 * kb, n0 = 32 * nb;
#pragma unroll 8
    for (int i = 0; i < 32; ++i) { const int kk = 2 * i + (lane >> 5); scr[kk * 33 + (lane & 31)] = W[(size_t)(k0 + kk) * N + n0 + (lane & 31)]; }
    LDS_WAIT(); asm volatile("" ::: "memory");
    const int c = lane & 7;
#pragma unroll
    for (int j = 0; j < 4; ++j) { const int n = (lane >> 3) + 8 * j; const LAS float* s = scr + (8 * c) * 33 + n;
        v4u o; o.x = pk2(s[0 * 33], s[1 * 33]); o.y = pk2(s[2 * 33], s[3 * 33]); o.z = pk2(s[4 * 33], s[5 * 33]); o.w = pk2(s[6 * 33], s[7 * 33]);
        *(GAS v4u*)(WT + (size_t)(n0 + n) * K + k0 + 8 * c) = o; }
    LDS_WAIT(); asm volatile("" ::: "memory");
}
__device__ __forceinline__ void p0_prologue(Frame& F) {
    LAS float* scr = (LAS float*)(F.lds + RING_OFF + F.wave * 16384);
    const int gw = F.vcu * NWAVES + F.wave, NGW = F.G * NWAVES;
    constexpr int I_IN = (DM / 64) * (NPROJ / 32), I_GLU = (512 / 64) * (512 / 32), I_UP = (512 / 64) * (DM / 32), I_OUT = (DM / 64) * (DM / 32);
    constexpr int I_MOD = 48 * KSL;
    constexpr int NITEMS = I_IN + I_GLU + 2 * I_UP + I_OUT + I_MOD;
    bf16* ws16 = (bf16*)F.ws;
    for (int r = gw; r < I_MOD; r += NGW) {
            const int cg = r / KSL, ks = r % KSL, n = cg * 64 + F.lane, k0 = ks * 128;
            const float* c = F.in[1]; const float* wa = F.in[3];
            for (int i = F.lane; i < 16 * 128; i += 64) { const int b = i >> 7, k = i & 127; const float cv = c[b * DM + k0 + k]; scr[i] = cv * sigm(cv); }
            LDS_WAIT(); asm volatile("" ::: "memory");
            float acc[16];
#pragma unroll
            for (int b = 0; b < 16; ++b) acc[b] = 0.f;
            for (int kk = 0; kk < 128; kk += 16) { float w[16];
#pragma unroll
                for (int j = 0; j < 16; ++j) w[j] = wa[(size_t)(k0 + kk + j) * 3072 + n];
#pragma unroll
                for (int j4 = 0; j4 < 16; j4 += 4)
#pragma unroll
                    for (int b = 0; b < 16; ++b) { const f32x4 s4 = *(const LAS f32x4*)(scr + b * 128 + kk + j4); acc[b] += (s4[0] * w[j4] + s4[1] * w[j4 + 1]) + (s4[2] * w[j4 + 2] + s4[3] * w[j4 + 3]); } }
            float* mp = (float*)(F.ws + WS_MODP) + (size_t)ks * 16 * 3072;
#pragma unroll
            for (int b = 0; b < 16; ++b) mp[b * 3072 + n] = acc[b];
            LDS_WAIT(); asm volatile("" ::: "memory");
    }
    for (int it = NGW - 1 - gw; it < NITEMS - I_MOD; it += NGW) {
        int r = it;
        if (r < I_IN) { p0_transpose_item(F.in[6], DM, NPROJ, ws16 + WS_WIN / 2, scr, r, F.lane); continue; } r -= I_IN;
        if (r < I_GLU) { p0_transpose_item(F.in[17], 512, 512, ws16 + WS_WGLU / 2, scr, r, F.lane); continue; } r -= I_GLU;
        if (r < I_UP) { p0_transpose_item(F.in[19], 512, DM, ws16 + WS_WUPA / 2, scr, r, F.lane); continue; } r -= I_UP;
        if (r < I_UP) { p0_transpose_item(F.in[20], 512, DM, ws16 + WS_WUPS / 2, scr, r, F.lane); continue; } r -= I_UP;
        p0_transpose_item(F.in[21], DM, DM, ws16 + WS_WOUT / 2, scr, r, F.lane);
    }
    { const int* pos = (const int*)F.in[2]; float* rope = (float*)(F.ws + WS_ROPE);
      for (int idx = (F.vcu * 512 + F.tid); idx < M * 8; idx += F.G * 512) { const int tok = idx >> 3, i = idx & 7;
          const float invf = __builtin_amdgcn_exp2f(-(float)i * (18.931568569324174f / 8.0f));
          const float ang = (float)pos[tok] * invf;
          rope[tok * 16 + i] = cos_rev(ang); rope[tok * 16 + 8 + i] = sin_rev(ang); } }
}

__device__ __forceinline__ void p1a_norm(Frame& F) {
    LAS float* gs = (LAS float*)(F.lds + RING_OFF); LAS float* sh = gs + 1024;
    const float* modp = (const float*)(F.ws + WS_MODP); const float* b_ada = F.in[4]; const float* g_pre = F.in[5];
    const int rows_per = M / F.G;
    const int r0 = F.vcu * rows_per, b = r0 / SEQ;
    for (int k = F.tid; k < 1024; k += 512) {
        float s_sh = b_ada[k], s_sc = b_ada[1024 + k];
#pragma unroll
        for (int ks = 0; ks < KSL; ++ks) { s_sh += modp[((size_t)ks * 16 + b) * 3072 + k]; s_sc += modp[((size_t)ks * 16 + b) * 3072 + 1024 + k]; }
        gs[k] = g_pre[k] * (1.0f + s_sc); sh[k] = s_sh; }
    { const int sub = (r0 % SEQ) / rows_per;
      if (F.tid < 64 && sub < 16) { const int k = sub * 64 + F.tid; float s = b_ada[2048 + k];
#pragma unroll
          for (int ks = 0; ks < KSL; ++ks) s += modp[((size_t)ks * 16 + b) * 3072 + 2048 + k];
          ((float*)(F.ws + WS_GATE))[b * 1024 + k] = s; } }
    LDS_WAIT(); __syncthreads();
    bf16* H = (bf16*)(F.ws + WS_H);
    for (int r = r0 + F.wave; r < r0 + rows_per; r += NWAVES) {
        const GAS f32x4* xr = (const GAS f32x4*)(F.in[0] + (size_t)r * DM) + F.lane;
        f32x4 v[4]; float s = 0.f;
#pragma unroll
        for (int j = 0; j < 4; ++j) { v[j] = xr[64 * j]; s += (v[j].x * v[j].x + v[j].y * v[j].y) + (v[j].z * v[j].z + v[j].w * v[j].w); }
        const float inv = 1.0f / sqrtf(wave_sum(s) * (1.f / DM) + EPS);
        GAS unsigned long long* o8 = (GAS unsigned long long*)(H + (size_t)r * DM) + F.lane;
#pragma unroll
        for (int j = 0; j < 4; ++j) { const int k = 4 * F.lane + 256 * j; const f32x4 g = *(const LAS f32x4*)(gs + k), s4 = *(const LAS f32x4*)(sh + k);
            const f32x4 h = v[j] * inv * g + s4;
            o8[64 * j] = (unsigned long long)pk2(h.x, h.y) | ((unsigned long long)pk2(h.z, h.w) << 32); }
    }
    __syncthreads();
}

__device__ __forceinline__ void attn_naive_unit(Frame& F, int unit) {
    const int qb = unit & 31, bh = unit >> 5, h = bh & 3, b = bh >> 2;
    const int t = F.tid, row = t & 63, c = (t >> 6) & 1, dq = t >> 7;
    const bf16* QKV = (const bf16*)(F.ws + WS_QKV);
    LAS unsigned char* Kl = F.lds + RING_OFF; LAS unsigned char* Vl = Kl + 8192; LAS float* X = (LAS float*)(F.lds + RING_OFF + 32768); LAS float* SS = X + 64 * 128;
    float q[64];
    { const v4u* qp = (const v4u*)(QKV + (size_t)(b * SEQ + qb * 64 + row) * QKVW + h * 128 + c * 64);
#pragma unroll
      for (int i = 0; i < 8; ++i) { const v4u w = qp[i]; q[8 * i] = bflo(w.x); q[8 * i + 1] = bfhi(w.x); q[8 * i + 2] = bflo(w.y); q[8 * i + 3] = bfhi(w.y);
          q[8 * i + 4] = bflo(w.z); q[8 * i + 5] = bfhi(w.z); q[8 * i + 6] = bflo(w.w); q[8 * i + 7] = bfhi(w.w); } }
    float o[32];
#pragma unroll
    for (int j = 0; j < 32; ++j) o[j] = 0.f;
    float mrun = -1e30f, l = 0.f;
    const int lk = t >> 4, lc = t & 15;
    for (int kt = 0; kt < SEQ / 32; ++kt) {
        __syncthreads();
        { const size_t rowoff = (size_t)(b * SEQ + kt * 32 + lk) * QKVW + h * 128 + lc * 8;
          *(LAS v4u*)(Kl + lk * 256 + lc * 16) = *(const v4u*)(QKV + rowoff + 512);
          *(LAS v4u*)(Vl + lk * 256 + lc * 16) = *(const v4u*)(QKV + rowoff + 1024); }
        LDS_WAIT(); __syncthreads();
#pragma unroll 1
        for (int key = 0; key < 32; ++key) {
            const LAS unsigned char* Kg = Kl + key * 256 + c * 128; const LAS unsigned char* Vg = Vl + key * 256 + dq * 64;
            float a = 0.f;
#pragma unroll
            for (int i = 0; i < 8; ++i) { const v4u w = *(const LAS v4u*)(Kg + i * 16);
                a += q[8 * i] * bflo(w.x) + q[8 * i + 1] * bfhi(w.x) + q[8 * i + 2] * bflo(w.y) + q[8 * i + 3] * bfhi(w.y)
                   + q[8 * i + 4] * bflo(w.z) + q[8 * i + 5] * bfhi(w.z) + q[8 * i + 6] * bflo(w.w) + q[8 * i + 7] * bfhi(w.w); }
            const float mn = fmaxf(mrun, a), alpha = __builtin_amdgcn_exp2f(mrun - mn), p = __builtin_amdgcn_exp2f(a - mn); mrun = mn;
            l = l * alpha + p;
#pragma unroll
            for (int i = 0; i < 4; ++i) { const v4u w = *(const LAS v4u*)(Vg + i * 16);
                o[8 * i] = o[8 * i] * alpha + p * bflo(w.x); o[8 * i + 1] = o[8 * i + 1] * alpha + p * bfhi(w.x); o[8 * i + 2] = o[8 * i + 2] * alpha + p * bflo(w.y); o[8 * i + 3] = o[8 * i + 3] * alpha + p * bfhi(w.y);
                o[8 * i + 4] = o[8 * i + 4] * alpha + p * bflo(w.z); o[8 * i + 5] = o[8 * i + 5] * alpha + p * bfhi(w.z); o[8 * i + 6] = o[8 * i + 6] * alpha + p * bflo(w.w); o[8 * i + 7] = o[8 * i + 7] * alpha + p * bfhi(w.w); }
        }
    }
    const float rl = 1.0f / l;
    float lam; { const float* lq = F.in[7]; float d1 = 0.f, d2 = 0.f; for (int i = 0; i < 64; ++i) { d1 += lq[i] * lq[64 + i]; d2 += lq[128 + i] * lq[192 + i]; } lam = __expf(d1) - __expf(d2) + LAM_INIT; }
    __syncthreads();
    if (c == 1) {
#pragma unroll
        for (int j = 0; j < 32; ++j) X[row * 128 + dq * 32 + j] = o[j] * rl; }
    LDS_WAIT(); __syncthreads();
    float ss = 0.f;
    if (c == 0) {
#pragma unroll
        for (int j = 0; j < 32; ++j) { o[j] = o[j] * rl - lam * X[row * 128 + dq * 32 + j]; ss += o[j] * o[j]; }
        SS[row * 4 + dq] = ss; }
    LDS_WAIT(); __syncthreads();
    if (c == 0) {
        const float inv = 1.0f / sqrtf(((SS[row * 4] + SS[row * 4 + 1]) + (SS[row * 4 + 2] + SS[row * 4 + 3])) * (1.0f / 128.0f) + EPS) * (1.0f - LAM_INIT);
        const float* gsub = F.in[8]; const size_t tok = (size_t)(b * SEQ + qb * 64 + row);
        const v4u* zp = (const v4u*)((const bf16*)(F.ws + WS_ZA) + tok * 512 + h * 128 + dq * 32);
        v4u* op = (v4u*)((bf16*)(F.ws + WS_AIN) + tok * 512 + h * 128 + dq * 32);
#pragma unroll
        for (int i = 0; i < 4; ++i) { const v4u z = zp[i]; float r[8];
#pragma unroll
            for (int e = 0; e < 8; ++e) r[e] = o[8 * i + e] * inv * gsub[dq * 32 + 8 * i + e];
            r[0] *= bflo(z.x); r[1] *= bfhi(z.x); r[2] *= bflo(z.y); r[3] *= bfhi(z.y); r[4] *= bflo(z.z); r[5] *= bfhi(z.z); r[6] *= bflo(z.w); r[7] *= bfhi(z.w);
            v4u w; w.x = pk2(r[0], r[1]); w.y = pk2(r[2], r[3]); w.z = pk2(r[4], r[5]); w.w = pk2(r[6], r[7]); op[i] = w; } }
    __syncthreads();
}

__device__ __forceinline__ float gelu_tanh(float x) { const float u = 0.7978845608028654f * (x + 0.044715f * x * x * x); const float e = __builtin_amdgcn_exp2f(2.0f * LOG2E * u); const float th = 1.0f - 2.0f * __builtin_amdgcn_rcpf(e + 1.0f); return 0.5f * x * (1.0f + th); }
__device__ __forceinline__ void ssm_naive_unit(Frame& F, int unit) {
    const int g = unit & 31, b = unit >> 5, p = F.lane;
    const bf16* U = (const bf16*)(F.ws + WS_U); float* YT = (float*)(F.ws + WS_YTMP); bf16* Y = (bf16*)(F.ws + WS_Y);
    const float* dsk = F.in[16];
    for (int d = 0; d < 2; ++d) {
        const int pg = (d * NG + g);
        const float dt = __expf(F.in[11][pg]);
        const float lr = fminf(F.in[9][pg * NP + p], -1e-4f), li = F.in[10][pg * NP + p];
        const float mag = __expf(lr * dt); const float are = mag * cos_rev(li * dt), aim = mag * sin_rev(li * dt);
        const float den = lr * lr + li * li, nr = are - 1.0f, ni = aim; const float cre_ = (nr * lr + ni * li) / den, cim_ = (ni * lr - nr * li) / den;
        float bre[16], bim[16], cre[16], cim[16];
#pragma unroll
        for (int h = 0; h < 16; ++h) { const float br = F.in[12][((size_t)pg * NP + p) * GH + h], bi = F.in[13][((size_t)pg * NP + p) * GH + h];
            bre[h] = cre_ * br - cim_ * bi; bim[h] = cre_ * bi + cim_ * br;
            cre[h] = F.in[14][((size_t)pg * GH + h) * NP + p]; cim[h] = F.in[15][((size_t)pg * GH + h) * NP + p]; }
        float xr = 0.f, xi = 0.f;
        const int hsel = ((p >> 5) & 1) * 8 + ((p >> 4) & 1) * 4 + ((p >> 3) & 1) * 2 + ((p >> 2) & 1);
        const float dv = dsk[g * GH + hsel];
        for (int st = 0; st < SEQ; ++st) {
            const int t = d ? (SEQ - 1 - st) : st; const size_t tok = (size_t)b * SEQ + t;
            const v4u* up = (const v4u*)(U + tok * SSMW + g * GH); const v4u w0 = up[0], w1 = up[1];
            float u[16]; u[0] = bflo(w0.x); u[1] = bfhi(w0.x); u[2] = bflo(w0.y); u[3] = bfhi(w0.y); u[4] = bflo(w0.z); u[5] = bfhi(w0.z); u[6] = bflo(w0.w); u[7] = bfhi(w0.w);
            u[8] = bflo(w1.x); u[9] = bfhi(w1.x); u[10] = bflo(w1.y); u[11] = bfhi(w1.y); u[12] = bflo(w1.z); u[13] = bfhi(w1.z); u[14] = bflo(w1.w); u[15] = bfhi(w1.w);
            float br = 0.f, bi = 0.f;
#pragma unroll
            for (int h = 0; h < 16; ++h) { br += bre[h] * u[h]; bi += bim[h] * u[h]; }
            const float nxr = are * xr - aim * xi + br, nxi = are * xi + aim * xr + bi; xr = nxr; xi = nxi;
            float v[16];
#pragma unroll
            for (int h = 0; h < 16; ++h) v[h] = cre[h] * xr - cim[h] * xi;
            float w8[8], w4[4], w2[2], w1_;
            { const bool hi = (p & 32) != 0;
#pragma unroll
              for (int k = 0; k < 8; ++k) { const float send = hi ? v[k] : v[k + 8], keep = hi ? v[k + 8] : v[k]; w8[k] = keep + __shfl_xor(send, 32); } }
            { const bool hi = (p & 16) != 0;
#pragma unroll
              for (int k = 0; k < 4; ++k) { const float send = hi ? w8[k] : w8[k + 4], keep = hi ? w8[k + 4] : w8[k]; w4[k] = keep + __shfl_xor(send, 16); } }
            { const bool hi = (p & 8) != 0;
#pragma unroll
              for (int k = 0; k < 2; ++k) { const float send = hi ? w4[k] : w4[k + 2], keep = hi ? w4[k + 2] : w4[k]; w2[k] = keep + __shfl_xor(send, 8); } }
            { const bool hi = (p & 4) != 0; const float send = hi ? w2[0] : w2[1], keep = hi ? w2[1] : w2[0]; w1_ = keep + __shfl_xor(send, 4); }
            w1_ += __shfl_xor(w1_, 2); w1_ += __shfl_xor(w1_, 1);
            if ((p & 3) == 0) {
                if (d == 0) YT[tok * SSMW + g * GH + hsel] = w1_;
                else { const float uh = __uint_as_float((unsigned)U[tok * SSMW + g * GH + hsel] << 16);
                       const float y = YT[tok * SSMW + g * GH + hsel] + w1_ + dv * uh; Y[tok * SSMW + g * GH + hsel] = (bf16)f2bf(gelu_tanh(y)); } }
        }
        asm volatile("s_waitcnt vmcnt(0)" ::: "memory");
    }
}

__device__ __forceinline__ void p6_final_norm(Frame& F) {
    const int gw = F.vcu * NWAVES + F.wave, NGW = F.G * NWAVES;
    const float* rowss = (const float*)(F.ctl + CW_ROWSS); const float* gf = F.in[22];
    f32x4 g4[4];
#pragma unroll
    for (int j = 0; j < 4; ++j) g4[j] = *(const f32x4*)(gf + 4 * F.lane + 256 * j);
    for (int r = gw; r < M; r += NGW) { const float inv = 1.0f / sqrtf(rowss[r] * (1.f / DM) + EPS);
        GAS f32x4* o = (GAS f32x4*)(F.out + (size_t)r * DM) + F.lane;
#pragma unroll
        for (int j = 0; j < 4; ++j) o[64 * j] = o[64 * j] * inv * g4[j]; }
}
namespace att {
using bf16x8 = __attribute__((ext_vector_type(8))) short;
using s16x4  = __attribute__((ext_vector_type(4))) short;
using f32x16 = __attribute__((ext_vector_type(16))) float;
using u32x4  = __attribute__((ext_vector_type(4))) unsigned;
constexpr int QBLK = 32, KVBLK = 64, LDR = QKVW;
constexpr size_t SHM_V = KVBLK * 128 * 2, SHM_K = KVBLK * 128 * 2, SHM_ATTN = 2 * SHM_V + 2 * SHM_K + NWAVES * 64 * 4;
constexpr float THRL = 8.f * LOG2E;
#define KSWZ(row, colB) ((row) * 256 + ((colB) ^ (((row) & 7) << 4)))
#define SBAR() __builtin_amdgcn_sched_barrier(0)
__device__ __forceinline__ int crow(int r, int hi) { return (r & 3) + 8 * (r >> 2) + 4 * hi; }
__device__ __forceinline__ unsigned cvtpk(float lo, float hi) { unsigned r; asm volatile("v_cvt_pk_bf16_f32 %0, %1, %2" : "=v"(r) : "v"(lo), "v"(hi)); return r; }
__device__ __forceinline__ void partialSM(f32x16& p0, f32x16& p1, float& m_reg, float& mn, float& alpha) {
  float pmax = p0[0];
#pragma unroll
  for (int r = 1; r < 16; ++r) pmax = fmaxf(pmax, p0[r]);
#pragma unroll
  for (int r = 0; r < 16; ++r) pmax = fmaxf(pmax, p1[r]);
  { auto rr = __builtin_amdgcn_permlane32_swap(__float_as_uint(pmax), __float_as_uint(pmax), false, false);
    pmax = fmaxf(__uint_as_float(rr[0]), __uint_as_float(rr[1])); }
  if (__builtin_expect(__all(pmax - m_reg <= THRL), 1)) { mn = m_reg; alpha = 1.f; }
  else { mn = fmaxf(m_reg, pmax); alpha = __builtin_amdgcn_exp2f(m_reg - mn); m_reg = mn; }
#pragma unroll
  for (int r = 0; r < 16; ++r) p0[r] -= mn;
#pragma unroll
  for (int r = 0; r < 16; ++r) p1[r] -= mn;
#pragma unroll
  for (int r = 0; r < 16; ++r) p0[r] = __builtin_amdgcn_exp2f(p0[r]);
}
__device__ __forceinline__ void finishSM(f32x16& p0, f32x16& p1, float alpha, float& l_reg, bf16x8& pa0, bf16x8& pa1, bf16x8& pa2, bf16x8& pa3) {
#pragma unroll
  for (int r = 0; r < 16; ++r) p1[r] = __builtin_amdgcn_exp2f(p1[r]);
  float ps = 0;
#pragma unroll
  for (int r = 0; r < 16; ++r) ps += p0[r];
#pragma unroll
  for (int r = 0; r < 16; ++r) ps += p1[r];
  { auto rr = __builtin_amdgcn_permlane32_swap(__float_as_uint(ps), __float_as_uint(ps), false, false);
    ps = __uint_as_float(rr[0]) + __uint_as_float(rr[1]); }
  l_reg = l_reg * alpha + ps;
#define PK4(P, BASE, OUT) do { unsigned a0 = cvtpk(P[BASE + 0], P[BASE + 1]), a1 = cvtpk(P[BASE + 2], P[BASE + 3]);   \
    unsigned b0 = cvtpk(P[BASE + 4], P[BASE + 5]), b1 = cvtpk(P[BASE + 6], P[BASE + 7]);                              \
    auto r0 = __builtin_amdgcn_permlane32_swap(a0, b0, false, false); auto r1 = __builtin_amdgcn_permlane32_swap(a1, b1, false, false); \
    u32x4 w = {r0[0], r1[0], r0[1], r1[1]}; OUT = *reinterpret_cast<bf16x8*>(&w); } while (0)
  PK4(p0, 0, pa0); PK4(p0, 8, pa1); PK4(p1, 0, pa2); PK4(p1, 8, pa3);
#undef PK4
}
__device__ __forceinline__ void qkt(f32x16& p0, f32x16& p1, const char* Ks, const bf16x8* qr, int r32, int hi, int cofs) {
  p0 = f32x16{}; p1 = f32x16{};
#pragma unroll
  for (int d0 = 0; d0 < 4; ++d0) { const int cb = cofs + (d0 * 16 + hi * 8) * 2;
    const bf16x8 b0 = *reinterpret_cast<const bf16x8*>(Ks + KSWZ(r32, cb));
    const bf16x8 b1 = *reinterpret_cast<const bf16x8*>(Ks + KSWZ(32 + r32, cb));
    p0 = __builtin_amdgcn_mfma_f32_32x32x16_bf16(b0, qr[d0], p0, 0, 0, 0);
    p1 = __builtin_amdgcn_mfma_f32_32x32x16_bf16(b1, qr[d0], p1, 0, 0, 0); }
}
__device__ __forceinline__ int v_st(int k, int c) { const int kk = (k & ~0xC) | ((k & 4) << 1) | ((k & 8) >> 1); return ((kk >> 3) * 4 + (c >> 5)) * 512 + ((kk & 7) * 32 + (c & 31)) * 2; }
__device__ __forceinline__ int v_rd_base(int lane) { return ((lane & 3) << 3) | (((lane >> 2) & 3) << 6) | (((lane >> 4) & 1) << 5) | (((lane >> 5) & 1) << 8); }
constexpr int v_rd_off(int d0, int ks, int half) { return d0 * 512 + ks * 4096 + half * 2048; }
template <int OFF> __device__ __forceinline__ s16x4 tr_read(int vb) {
  s16x4 r; asm volatile("ds_read_b64_tr_b16 %0, %1 offset:%2" : "=&v"(r) : "v"(vb), "i"(OFF) : "memory"); return r;
}
template <int D0> __device__ __forceinline__ void pv_one(f32x16& od, int vb, bf16x8 pa0, bf16x8 pa1, bf16x8 pa2, bf16x8 pa3) {
  const s16x4 l0 = tr_read<v_rd_off(D0, 0, 0)>(vb), h0 = tr_read<v_rd_off(D0, 0, 1)>(vb), l1 = tr_read<v_rd_off(D0, 1, 0)>(vb), h1 = tr_read<v_rd_off(D0, 1, 1)>(vb);
  const s16x4 l2 = tr_read<v_rd_off(D0, 2, 0)>(vb), h2 = tr_read<v_rd_off(D0, 2, 1)>(vb), l3 = tr_read<v_rd_off(D0, 3, 0)>(vb), h3 = tr_read<v_rd_off(D0, 3, 1)>(vb);
  asm volatile("s_waitcnt lgkmcnt(0)" ::: "memory"); SBAR();
#define PK(L, H) (bf16x8){L[0], L[1], L[2], L[3], H[0], H[1], H[2], H[3]}
  od = __builtin_amdgcn_mfma_f32_32x32x16_bf16(pa0, PK(l0, h0), od, 0, 0, 0);
  od = __builtin_amdgcn_mfma_f32_32x32x16_bf16(pa1, PK(l1, h1), od, 0, 0, 0);
  od = __builtin_amdgcn_mfma_f32_32x32x16_bf16(pa2, PK(l2, h2), od, 0, 0, 0);
  od = __builtin_amdgcn_mfma_f32_32x32x16_bf16(pa3, PK(l3, h3), od, 0, 0, 0);
#undef PK
}
__device__ __forceinline__ void pv_d0(f32x16* o, int vb, bf16x8 pa0, bf16x8 pa1, bf16x8 pa2, bf16x8 pa3) {
  pv_one<0>(o[0], vb, pa0, pa1, pa2, pa3); pv_one<1>(o[1], vb, pa0, pa1, pa2, pa3); pv_one<2>(o[2], vb, pa0, pa1, pa2, pa3); pv_one<3>(o[3], vb, pa0, pa1, pa2, pa3);
}
__device__ __forceinline__ void attn_unit(int b, int h, int qb, const unsigned short* __restrict__ QKVb, const unsigned short* __restrict__ ZA, unsigned short* __restrict__ AIN,
                                          const float* __restrict__ gsub, float lam, char* lds) {
  const int tid = threadIdx.x, wid = tid >> 6, lane = tid & 63, r32 = lane & 31, hi = lane >> 5, c = wid >> 2, wq = wid & 3;
  char* V_lds = lds; char* K_lds = lds + 2 * SHM_V;
  float* ws = (float*)(lds + 2 * SHM_V + 2 * SHM_K) + wid * 64; float* li_l = ws; float* al_l = ws + 32;
  float m_reg = -1e30f, l_reg = 0; f32x16 o[4] = {}; bf16x8 qr[4];
  const long tok0 = (long)b * SEQ + qb * 128;
  const unsigned short* Qw = QKVb + (tok0 + wq * QBLK + r32) * LDR + h * 128 + c * 64 + hi * 8;
#pragma unroll
  for (int d0 = 0; d0 < 4; ++d0) qr[d0] = *reinterpret_cast<const bf16x8*>(Qw + d0 * 16);
  const unsigned short* Kh = QKVb + (long)b * SEQ * LDR + 512 + h * 128; const unsigned short* Vh = Kh + 512;
  const int cofs = c * 128;
  const int sr = tid >> 4, sc = (tid & 15) * 8, vst0 = v_st(sr, sc), vst1 = v_st(32 + sr, sc);
  const int vb0 = (int)(uintptr_t)V_lds + v_rd_base(lane);
  struct { bf16x8 vs0, vs1, ks0, ks1; } sr_[2];
#define SLOAD(i, k0) do { sr_[i].vs0 = *reinterpret_cast<const bf16x8*>(&Vh[(long)((k0) + sr) * LDR + sc]); sr_[i].vs1 = *reinterpret_cast<const bf16x8*>(&Vh[(long)((k0) + 32 + sr) * LDR + sc]); \
    sr_[i].ks0 = *reinterpret_cast<const bf16x8*>(&Kh[(long)((k0) + sr) * LDR + sc]); sr_[i].ks1 = *reinterpret_cast<const bf16x8*>(&Kh[(long)((k0) + 32 + sr) * LDR + sc]); } while (0)
#define SWRITE(bb, i) do { *(bf16x8*)(V_lds + (bb) * SHM_V + vst0) = sr_[i].vs0;          \
    *(bf16x8*)(V_lds + (bb) * SHM_V + vst1) = sr_[i].vs1; const int kc = sc * 2;               \
    *(bf16x8*)(K_lds + (bb) * SHM_K + KSWZ(sr, kc)) = sr_[i].ks0;                       \
    *(bf16x8*)(K_lds + (bb) * SHM_K + KSWZ(32 + sr, kc)) = sr_[i].ks1; } while (0)
#define SWAIT() asm volatile("s_waitcnt vmcnt(4)" ::: "memory")
#define RESC(a) do { if (__any((a) < 1.f)) { if (hi == 0) al_l[r32] = (a); asm volatile("s_waitcnt lgkmcnt(0)" ::: "memory"); \
    _Pragma("unroll") for (int d = 0; d < 4; ++d) _Pragma("unroll") for (int r = 0; r < 16; ++r) o[d][r] *= al_l[crow(r, hi)]; } } while (0)
  f32x16 pA0, pA1, pB0, pB1; float mnA, mnB, alA, alB; bf16x8 pa0, pa1, pa2, pa3; constexpr int NT = SEQ / KVBLK;
  constexpr int SE = 0, SO = 1;
  SLOAD(SE, 0); asm volatile("s_waitcnt vmcnt(0)" ::: "memory"); SWRITE(0, SE); __syncthreads();
  qkt(pA0, pA1, K_lds, qr, r32, hi, cofs); partialSM(pA0, pA1, m_reg, mnA, alA);
  SLOAD(SO, KVBLK); SLOAD(SE, 2 * KVBLK);
  SWAIT(); SWRITE(1, SO); __syncthreads();
  for (int j = 1; j + 1 < NT; j += 2) {
    SBAR(); qkt(pB0, pB1, K_lds + SHM_K, qr, r32, hi, cofs);
    finishSM(pA0, pA1, alA, l_reg, pa0, pa1, pa2, pa3); SBAR();
    SLOAD(SO, (j + 2) * KVBLK); SBAR();
    pv_d0(o, vb0, pa0, pa1, pa2, pa3); partialSM(pB0, pB1, m_reg, mnB, alB);
    __syncthreads(); SWAIT(); SWRITE(0, SE);
    RESC(alB); __syncthreads();
    SBAR(); qkt(pA0, pA1, K_lds, qr, r32, hi, cofs);
    finishSM(pB0, pB1, alB, l_reg, pa0, pa1, pa2, pa3); SBAR();
    if (j + 3 < NT) SLOAD(SE, (j + 3) * KVBLK); SBAR();
    pv_d0(o, vb0 + (int)SHM_V, pa0, pa1, pa2, pa3); partialSM(pA0, pA1, m_reg, mnA, alA);
    __syncthreads(); SWAIT(); SWRITE(1, SO);
    RESC(alA); __syncthreads();
  }
  SBAR(); qkt(pB0, pB1, K_lds + SHM_K, qr, r32, hi, cofs);
  finishSM(pA0, pA1, alA, l_reg, pa0, pa1, pa2, pa3); SBAR();
  pv_d0(o, vb0, pa0, pa1, pa2, pa3); partialSM(pB0, pB1, m_reg, mnB, alB);
  __syncthreads(); RESC(alB);
  finishSM(pB0, pB1, alB, l_reg, pa0, pa1, pa2, pa3); SBAR();
  pv_d0(o, vb0 + (int)SHM_V, pa0, pa1, pa2, pa3);
  if (hi == 0) li_l[r32] = l_reg; asm volatile("s_waitcnt lgkmcnt(0)" ::: "memory");
  float rli[16];
#pragma unroll
  for (int r = 0; r < 16; ++r) rli[r] = __builtin_amdgcn_rcpf(li_l[crow(r, hi)]);
  float* X = (float*)lds + wq * (64 * 64);
  __syncthreads();
  if (c == 1) {
#pragma unroll
    for (int r = 0; r < 16; ++r)
#pragma unroll
      for (int d0 = 0; d0 < 4; ++d0) X[(r * 4 + d0) * 64 + lane] = o[d0][r] * rli[r];
  }
  __syncthreads();
  if (c == 0) {
#pragma unroll
    for (int r = 0; r < 16; ++r)
#pragma unroll
      for (int d0 = 0; d0 < 4; ++d0) o[d0][r] = o[d0][r] * rli[r] - lam * X[(r * 4 + d0) * 64 + lane];
  }
  __syncthreads();
  if (c == 0) {
    float gs[4];
#pragma unroll
    for (int d0 = 0; d0 < 4; ++d0) gs[d0] = gsub[d0 * 32 + r32] * (1.0f - LAM_INIT);
#pragma unroll
    for (int r = 0; r < 16; ++r) {
      float ss = (o[0][r] * o[0][r] + o[1][r] * o[1][r]) + (o[2][r] * o[2][r] + o[3][r] * o[3][r]);
#pragma unroll
      for (int off = 1; off < 32; off <<= 1) ss += __shfl_xor(ss, off);
      const float inv = 1.0f / sqrtf(ss * (1.0f / 128.0f) + EPS);
      const long tok = tok0 + wq * QBLK + crow(r, hi); const unsigned short* zp = ZA + tok * 512 + h * 128 + r32; unsigned short* op = AIN + tok * 512 + h * 128 + r32;
#pragma unroll
      for (int d0 = 0; d0 < 4; ++d0) { const float z = __uint_as_float((unsigned)zp[d0 * 32] << 16); op[d0 * 32] = (unsigned short)f2bf(o[d0][r] * inv * gs[d0] * z); }
    }
  }
#undef SLOAD
#undef SWRITE
#undef SWAIT
#undef RESC
}
#undef KSWZ
#undef SBAR
}
namespace ssm {
using bf16x8 = __attribute__((ext_vector_type(8))) short;
using f32x16 = __attribute__((ext_vector_type(16))) float;
constexpr int L = 32, NC = 64;
constexpr size_t WAF_G = 8 * 32 * 512, WCF_G = 16 * 16 * 512, KT_G = 16384;
constexpr int U_OFF = 0, U_CH = 1040, S_OFF = 66560, S_LD = 65, KT_OFF = S_OFF, X_OFF = S_OFF + 128 * S_LD * 4, X_CH = 528, LDS_NEED = X_OFF + 64 * X_CH;
struct Disc { float lr, li, dt, cre, cim; };
__device__ __forceinline__ Disc disc(const float* lam_re, const float* lam_im, const float* log_dt, int pg, int p) {
    Disc d; d.dt = __expf(log_dt[pg]); d.lr = fminf(lam_re[pg * NP + p], -1e-4f); d.li = lam_im[pg * NP + p];
    const float mag = __expf(d.lr * d.dt), are = mag * cos_rev(d.li * d.dt), aim = mag * sin_rev(d.li * d.dt);
    const float den = d.lr * d.lr + d.li * d.li, nr = are - 1.0f, ni = aim; d.cre = (nr * d.lr + ni * d.li) / den; d.cim = (ni * d.lr - nr * d.li) / den; return d;
}
__device__ __forceinline__ void apow(const Disc& d, int n, float& re, float& im) { const float mag = __expf((float)n * d.lr * d.dt), ang = (float)n * (d.li * d.dt); re = mag * cos_rev(ang); im = mag * sin_rev(ang); }

__device__ __forceinline__ void build_waf(const float* const* in, unsigned short* WAF, int piece) {
    const int lane = piece & 63, i = (piece >> 6) & 31, mb = (piece >> 11) & 7, g = piece >> 14;
    const int k = 32 * mb + (lane & 31), dir = k >> 7, ri = (k >> 6) & 1, p = k & 63, hh = 8 * (lane >> 5), pg = dir * NG + g;
    const Disc d = disc(in[9], in[10], in[11], pg, p); float pr, pi; apow(d, dir ? i : (L - 1 - i), pr, pi);
    const float zr = pr * d.cre - pi * d.cim, zi = pr * d.cim + pi * d.cre;
    const float* br = in[12] + ((size_t)pg * NP + p) * GH + hh; const float* bi = in[13] + ((size_t)pg * NP + p) * GH + hh;
    float v[8];
#pragma unroll
    for (int e = 0; e < 8; ++e) v[e] = ri ? (zr * bi[e] + zi * br[e]) : (zr * br[e] - zi * bi[e]);
    v4u w; w.x = pk2(v[0], v[1]); w.y = pk2(v[2], v[3]); w.z = pk2(v[4], v[5]); w.w = pk2(v[6], v[7]); *(v4u*)(WAF + (size_t)piece * 8) = w;
}
__device__ __forceinline__ void build_wcf(const float* const* in, unsigned short* WCF, int piece) {
    const int lane = piece & 63, ks = (piece >> 6) & 15, mb = (piece >> 10) & 15, g = piece >> 14;
    const int m = lane & 31, j = 2 * mb + (m >> 4), h = m & 15, k0 = 16 * ks + 8 * (lane >> 5), dir = k0 >> 7, ri = (k0 >> 6) & 1, p0 = k0 & 63, pg = dir * NG + g;
    float v[8];
#pragma unroll
    for (int e = 0; e < 8; ++e) { const int p = p0 + e; const Disc d = disc(in[9], in[10], in[11], pg, p); float pr, pi; apow(d, dir ? (L - j) : (j + 1), pr, pi);
        const float cr = in[14][((size_t)pg * GH + h) * NP + p], ci = in[15][((size_t)pg * GH + h) * NP + p];
        v[e] = ri ? -(cr * pi + ci * pr) : (cr * pr - ci * pi); }
    v4u w; w.x = pk2(v[0], v[1]); w.y = pk2(v[2], v[3]); w.z = pk2(v[4], v[5]); w.w = pk2(v[6], v[7]); *(v4u*)(WCF + (size_t)piece * 8) = w;
}
__device__ __forceinline__ void build_kt(const float* const* in, unsigned short* KT, int item, int lane, LAS float* scr) {
    const int tau = item % 63, g = item / 63, h = lane >> 2, hq = (lane & 3) * 4, n = tau >= 31 ? tau - 31 : 31 - tau;
    LAS float* Gr = scr; LAS float* Gi = scr + 1024; LAS float* Br = scr + 2048; LAS float* Bi = scr + 3072;
    float acc[4] = {0.f, 0.f, 0.f, 0.f};
    for (int dir = 0; dir < 2; ++dir) {
        if ((dir == 0 && tau < 31) || (dir == 1 && tau > 31)) continue;
        const int pg = dir * NG + g, p = lane;
        const Disc d = disc(in[9], in[10], in[11], pg, p); float pr, pi; apow(d, n, pr, pi);
        const float qr = pr * d.cre - pi * d.cim, qi = pr * d.cim + pi * d.cre;
        float cr[16], ci[16];
#pragma unroll
        for (int hh = 0; hh < 16; ++hh) { cr[hh] = in[14][((size_t)pg * GH + hh) * NP + p]; ci[hh] = in[15][((size_t)pg * GH + hh) * NP + p]; }
        float br[16], bi[16];
#pragma unroll
        for (int q4 = 0; q4 < 4; ++q4) { const f32x4 t = *(const f32x4*)(in[12] + (size_t)pg * NP * GH + q4 * 256 + lane * 4), u = *(const f32x4*)(in[13] + (size_t)pg * NP * GH + q4 * 256 + lane * 4);
            br[4 * q4] = t[0]; br[4 * q4 + 1] = t[1]; br[4 * q4 + 2] = t[2]; br[4 * q4 + 3] = t[3]; bi[4 * q4] = u[0]; bi[4 * q4 + 1] = u[1]; bi[4 * q4 + 2] = u[2]; bi[4 * q4 + 3] = u[3]; }
#pragma unroll
        for (int hh = 0; hh < 16; ++hh) { Gr[hh * 64 + p] = cr[hh] * qr - ci[hh] * qi; Gi[hh * 64 + p] = cr[hh] * qi + ci[hh] * qr; }
#pragma unroll
        for (int q4 = 0; q4 < 4; ++q4) { *(LAS f32x4*)(Br + q4 * 256 + lane * 4) = (f32x4){br[4 * q4], br[4 * q4 + 1], br[4 * q4 + 2], br[4 * q4 + 3]};
                                         *(LAS f32x4*)(Bi + q4 * 256 + lane * 4) = (f32x4){bi[4 * q4], bi[4 * q4 + 1], bi[4 * q4 + 2], bi[4 * q4 + 3]}; }
        LDS_WAIT(); asm volatile("" ::: "memory");
#pragma unroll 8
        for (int pp = 0; pp < NP; ++pp) { const float gr = Gr[h * 64 + pp], gi = Gi[h * 64 + pp]; const f32x4 b4 = *(const LAS f32x4*)(Br + pp * 16 + hq), c4 = *(const LAS f32x4*)(Bi + pp * 16 + hq);
#pragma unroll
            for (int q = 0; q < 4; ++q) acc[q] += gr * b4[q] - gi * c4[q]; }
        LDS_WAIT(); asm volatile("" ::: "memory");
    }
    const int half = hq >> 3; unsigned short* dst = KT + (size_t)g * KT_G + tau * 256 + h * 16 + ((half ^ (tau & 1)) * 8) + (hq & 7);
    *(unsigned long long*)dst = (unsigned long long)pk2(acc[0], acc[1]) | ((unsigned long long)pk2(acc[2], acc[3]) << 32);
}

__device__ __forceinline__ void ssm_unit(int b, int g, const float* const* in, const unsigned short* __restrict__ Ub, const unsigned short* __restrict__ WAF, const unsigned short* __restrict__ WCF,
                                         const unsigned short* __restrict__ KT, unsigned short* __restrict__ Y, LAS unsigned char* lds) {
    const int tid = threadIdx.x, wid = __builtin_amdgcn_readfirstlane(tid >> 6), lane = tid & 63, l31 = lane & 31, hi = lane >> 5;
    LAS unsigned char* U_l = lds + U_OFF; LAS float* S_l = (LAS float*)(lds + S_OFF); LAS unsigned char* KT_l = lds + KT_OFF; LAS unsigned char* X_l = lds + X_OFF;
#pragma unroll
    for (int it = 0; it < 8; ++it) { const int q = it * 512 + tid, tok = q >> 1, half = q & 1;
        const v4u w = *(const v4u*)(Ub + ((size_t)(b * SEQ + tok) * SSMW + g * GH + half * 8));
        *(LAS v4u*)(U_l + (tok >> 5) * U_CH + (tok & 31) * 32 + half * 16) = w; }
    LDS_WAIT(); __syncthreads();
    f32x16 sa0 = {}, sa1 = {};
    { const unsigned short* wa = WAF + (size_t)g * WAF_G + (size_t)wid * 32 * 512 + lane * 8; const LAS unsigned char* ub = U_l + l31 * U_CH + hi * 16;
#pragma unroll 8
      for (int i = 0; i < 32; ++i) { const bf16x8 a = *(const bf16x8*)(wa + i * 512);
          const bf16x8 b0 = *(const LAS bf16x8*)(ub + i * 32), b1 = *(const LAS bf16x8*)(ub + 32 * U_CH + i * 32);
          sa0 = __builtin_amdgcn_mfma_f32_32x32x16_bf16(a, b0, sa0, 0, 0, 0); sa1 = __builtin_amdgcn_mfma_f32_32x32x16_bf16(a, b1, sa1, 0, 0, 0); } }
    for (int d = 0; d < 2; ++d) {
        if ((wid >> 2) == d) {
#pragma unroll
            for (int r = 0; r < 16; ++r) { const int kk = 32 * (wid & 3) + (r & 3) + 8 * (r >> 2) + 4 * hi; S_l[kk * S_LD + l31] = sa0[r]; S_l[kk * S_LD + 32 + l31] = sa1[r]; } }
        LDS_WAIT(); __syncthreads();
        if (wid == 0) { const int p = lane; const Disc dd = disc(in[9], in[10], in[11], d * NG + g, p); float ar, ai; apow(dd, L, ar, ai);
            float xr = 0.f, xi = 0.f;
#pragma unroll 4
            for (int s = 0; s < NC; ++s) { const int c = d ? (NC - 1 - s) : s;
                LAS unsigned short* xp = (LAS unsigned short*)(X_l + c * X_CH) + d * 128 + p; xp[0] = (unsigned short)f2bf(xr); xp[64] = (unsigned short)f2bf(xi);
                const float sr = S_l[p * S_LD + c], si = S_l[(64 + p) * S_LD + c];
                const float nr = ar * xr - ai * xi + sr, ni = ar * xi + ai * xr + si; xr = nr; xi = ni; } }
        LDS_WAIT(); __syncthreads();
    }
#pragma unroll
    for (int it = 0; it < 4; ++it) { const int q = it * 512 + tid; if (q < 2016) *(LAS v4u*)(KT_l + q * 16) = *(const v4u*)(KT + (size_t)g * KT_G + q * 8); }
    LDS_WAIT(); __syncthreads();
    f32x16 acc[2][2] = {};
    { const unsigned short* wc0 = WCF + (size_t)g * WCF_G + (size_t)(2 * wid) * 16 * 512 + lane * 8; const LAS unsigned char* xb = X_l + l31 * X_CH + hi * 16;
#pragma unroll 4
      for (int ks = 0; ks < 16; ++ks) { const bf16x8 a0 = *(const bf16x8*)(wc0 + ks * 512), a1 = *(const bf16x8*)(wc0 + 16 * 512 + ks * 512);
          const bf16x8 b0 = *(const LAS bf16x8*)(xb + ks * 32), b1 = *(const LAS bf16x8*)(xb + 32 * X_CH + ks * 32);
          acc[0][0] = __builtin_amdgcn_mfma_f32_32x32x16_bf16(a0, b0, acc[0][0], 0, 0, 0); acc[0][1] = __builtin_amdgcn_mfma_f32_32x32x16_bf16(a0, b1, acc[0][1], 0, 0, 0);
          acc[1][0] = __builtin_amdgcn_mfma_f32_32x32x16_bf16(a1, b0, acc[1][0], 0, 0, 0); acc[1][1] = __builtin_amdgcn_mfma_f32_32x32x16_bf16(a1, b1, acc[1][1], 0, 0, 0); } }
    { const LAS unsigned char* ub = U_l + l31 * U_CH + hi * 16; const int jj = l31 >> 4, hrow = (l31 & 15) * 32;
#pragma unroll 4
      for (int i = 0; i < 32; ++i) { const bf16x8 b0 = *(const LAS bf16x8*)(ub + i * 32), b1 = *(const LAS bf16x8*)(ub + 32 * U_CH + i * 32);
          const int t0 = 4 * wid + jj - i + 31, t1 = t0 + 2;
          const bf16x8 a0 = *(const LAS bf16x8*)(KT_l + t0 * 512 + hrow + ((hi ^ (t0 & 1)) * 16)), a1 = *(const LAS bf16x8*)(KT_l + t1 * 512 + hrow + ((hi ^ (t1 & 1)) * 16));
          acc[0][0] = __builtin_amdgcn_mfma_f32_32x32x16_bf16(a0, b0, acc[0][0], 0, 0, 0); acc[0][1] = __builtin_amdgcn_mfma_f32_32x32x16_bf16(a0, b1, acc[0][1], 0, 0, 0);
          acc[1][0] = __builtin_amdgcn_mfma_f32_32x32x16_bf16(a1, b0, acc[1][0], 0, 0, 0); acc[1][1] = __builtin_amdgcn_mfma_f32_32x32x16_bf16(a1, b1, acc[1][1], 0, 0, 0); } }
    { const float* dsk = in[16] + g * GH;
#pragma unroll
      for (int mbi = 0; mbi < 2; ++mbi)
#pragma unroll
        for (int nb = 0; nb < 2; ++nb)
#pragma unroll
          for (int rq = 0; rq < 4; ++rq) { const int jj = rq >> 1, h0 = (rq & 1) * 8 + 4 * hi, n = 32 * nb + l31, j = 2 * (2 * wid + mbi) + jj, t = 32 * n + j;
              const unsigned long long uw = *(const LAS unsigned long long*)(U_l + n * U_CH + j * 32 + h0 * 2);
              const float u0 = bflo((unsigned)uw), u1 = bfhi((unsigned)uw), u2 = bflo((unsigned)(uw >> 32)), u3 = bfhi((unsigned)(uw >> 32));
              const float y0 = gelu_tanh(acc[mbi][nb][4 * rq + 0] + dsk[h0 + 0] * u0), y1 = gelu_tanh(acc[mbi][nb][4 * rq + 1] + dsk[h0 + 1] * u1);
              const float y2 = gelu_tanh(acc[mbi][nb][4 * rq + 2] + dsk[h0 + 2] * u2), y3 = gelu_tanh(acc[mbi][nb][4 * rq + 3] + dsk[h0 + 3] * u3);
              *(unsigned long long*)(Y + ((size_t)(b * SEQ + t) * SSMW + g * GH + h0)) = (unsigned long long)pk2(y0, y1) | ((unsigned long long)pk2(y2, y3) << 32); } }
    __syncthreads();
}
}
__device__ __forceinline__ void p0_ssm_tables(Frame& F) {
    unsigned short* WAF = (unsigned short*)(F.ws + WS_SSMT); unsigned short* WCF = WAF + (size_t)NG * ssm::WAF_G; unsigned short* KT = WCF + (size_t)NG * ssm::WCF_G;
    const int gt = F.vcu * 512 + F.tid, gs = F.G * 512;
    for (int piece = gt; piece < NG * 8 * 32 * 64; piece += gs) ssm::build_waf(F.in, WAF, piece);
    for (int piece = gt; piece < NG * 16 * 16 * 64; piece += gs) ssm::build_wcf(F.in, WCF, piece);
    const int gw = F.vcu * NWAVES + F.wave, NGW = F.G * NWAVES;
    LAS float* scr = (LAS float*)(F.lds + RING_OFF + F.wave * 17408);
    for (int item = gw; item < NG * 63; item += NGW) ssm::build_kt(F.in, KT, item, F.lane, scr);
}
#ifndef PROBE_DUP
#define PROBE_DUP -1
#endif
#define REPS(k) for (int rep_ = 0; rep_ < ((PROBE_DUP == (k)) ? 2 : 1); ++rep_)
#ifndef MK_N_LAUNCHES
#define MK_N_LAUNCHES 1
#endif
constexpr int N_PHASES = 9;
struct Args { const float* in[23]; float* out; unsigned char* ws; int ph_lo, ph_hi; };
__global__ void __launch_bounds__(NWAVES * 64, 2) fwd_kernel(Args args) {
    extern __shared__ __attribute__((aligned(16))) unsigned char lds[];
    Frame F;
    F.lds = (LAS unsigned char*)lds;
    F.MISC = (volatile LAS unsigned*)(F.lds + MISC_OFF);
    F.tid = threadIdx.x; F.lane = F.tid & 63; F.wave = __builtin_amdgcn_readfirstlane(F.tid >> 6);
    F.G = gridDim.x; { const int bx = blockIdx.x; F.vcu = (F.G % 8 == 0) ? (bx % 8) * (F.G / 8) + bx / 8 : bx; }
    F.ws = args.ws; F.out = args.out; F.ctl = (gu32*)(args.ws + WS_CTL);
#pragma unroll
    for (int i = 0; i < 23; ++i) F.in[i] = args.in[i];
    for (int u = F.tid; u < (LDS_BYTES - LDSCTL_OFF) / 4; u += NWAVES * 64) ((LAS unsigned*)(F.lds + LDSCTL_OFF))[u] = 0u;
    __syncthreads();
    const int lo = args.ph_lo, hi = args.ph_hi;
    const bool multi = (hi - lo) > 1;
    XcdBarrier bar; bar.bar = (unsigned*)(F.ctl + CW_BAR); bar.x = 0; bar.st = nullptr;
    if (multi) bar = xcd_barrier_post((unsigned*)(F.ctl + CW_BAR), F.MISC + 8);
#define IN(k) (lo <= (k) && (k) < hi)
#define SEAM(k) do { if (IN(k) && IN((k) + 1)) xcd_barrier(bar); } while (0)
    bf16* ws16 = (bf16*)args.ws;
    if (IN(0)) { REPS(0) { p0_prologue(F); p0_ssm_tables(F); } SEAM(0); }
    if (IN(1)) { REPS(1) p1a_norm(F); SEAM(1); }
    if (IN(2)) {
        pg8::Gemm g{ws16 + WS_H / 2, ws16 + WS_WIN / 2, M, NPROJ, DM}; pg8::StaticOrder S; S.init(M, NPROJ, F.G, (int)blockIdx.x);
        pg8::EpiProj E{ws16 + WS_QKV / 2, ws16 + WS_ZA / 2, ws16 + WS_U / 2, ws16 + WS_ZS / 2, ws16 + WS_GA / 2, ws16 + WS_GS / 2, (const float*)(args.ws + WS_ROPE), QSCALE};
        REPS(2) pg8::gemm_phase<pg8::EpiProj, pg8::StaticOrder, true, true>(F.lds + RING_OFF, g, S, E);
        SEAM(2); }
    if (IN(3)) {
#ifdef NAIVE_ATTN
        for (int u = F.vcu; u < NB * NH * 32; u += F.G) attn_naive_unit(F, u);
#else
        { float lam; { const float* lq = F.in[7]; float d1 = 0.f, d2 = 0.f; for (int i = 0; i < 64; ++i) { d1 += lq[i] * lq[64 + i]; d2 += lq[128 + i] * lq[192 + i]; } lam = __expf(d1) - __expf(d2) + LAM_INIT; }
          REPS(3) for (int u = F.vcu; u < NB * NH * 16; u += F.G) { const int bh = u >> 4, qb = u & 15;
              att::attn_unit(bh >> 2, bh & 3, qb, ws16 + WS_QKV / 2, ws16 + WS_ZA / 2, ws16 + WS_AIN / 2, F.in[8], lam, (char*)lds + RING_OFF); } }
#endif
#ifdef NAIVE_SSM
        { const int gw = F.vcu * NWAVES + F.wave; if ((gw & 3) == 0 && (gw >> 2) < NB * NG) ssm_naive_unit(F, gw >> 2); }
#else
        { const unsigned short* WAF = (const unsigned short*)(F.ws + WS_SSMT); const unsigned short* WCF = WAF + (size_t)NG * ssm::WAF_G; const unsigned short* KT = WCF + (size_t)NG * ssm::WCF_G;
          REPS(4) for (int u = F.vcu; u < NB * NG; u += F.G) { const int g = (u >> 3) & 31, b = (u & 7) + 8 * (u >> 8);
              ssm::ssm_unit(b, g, F.in, ws16 + WS_U / 2, WAF, WCF, KT, ws16 + WS_Y / 2, F.lds + RING_OFF); } }
#endif
        SEAM(3); }
    if (IN(4)) {
        pg8::Gemm g{ws16 + WS_Y / 2, ws16 + WS_WGLU / 2, M, 512, 512}; pg8::StaticOrder S; S.init(M, 512, F.G, (int)blockIdx.x);
        pg8::EpiGlu E{ws16 + WS_Y / 2, ws16 + WS_ZS / 2, ws16 + WS_Y2 / 2, F.in[18]};
        REPS(5) pg8::gemm_phase<pg8::EpiGlu, pg8::StaticOrder, true, true>(F.lds + RING_OFF, g, S, E);
        SEAM(4); }
    if (IN(5)) {
        pg8::Gemm g{ws16 + WS_AIN / 2, ws16 + WS_WUPA / 2, M, DM, 512}; pg8::StaticOrder S; S.init(M, DM, F.G, (int)blockIdx.x);
        pg8::EpiMerge<0> E{ws16 + WS_GA / 2, nullptr};
        pg8::gemm_phase<pg8::EpiMerge<0>, pg8::StaticOrder, true, true>(F.lds + RING_OFF, g, S, E);
        SEAM(5); }
    if (IN(6)) {
        pg8::Gemm g{ws16 + WS_Y2 / 2, ws16 + WS_WUPS / 2, M, DM, 512}; pg8::StaticOrder S; S.init(M, DM, F.G, (int)blockIdx.x);
        pg8::EpiMerge<1> E{ws16 + WS_GA / 2, ws16 + WS_GS / 2};
        pg8::gemm_phase<pg8::EpiMerge<1>, pg8::StaticOrder, true, true>(F.lds + RING_OFF, g, S, E);
        SEAM(6); }
    if (IN(7)) {
        pg8::Gemm g{ws16 + WS_GA / 2, ws16 + WS_WOUT / 2, M, DM, DM}; pg8::StaticOrder S; S.init(M, DM, F.G, (int)blockIdx.x);
        pg8::EpiOut E{F.in[0], (const float*)(args.ws + WS_GATE), F.out, (float*)(F.ctl + CW_ROWSS)};
        pg8::gemm_phase<pg8::EpiOut, pg8::StaticOrder, true, true>(F.lds + RING_OFF, g, S, E);
        SEAM(7); }
    if (IN(8)) { p6_final_norm(F); }
#undef IN
#undef SEAM
}

extern "C" void kernel_launch(void* const* d_in, const int* in_sizes, int n_in, void* d_out, int out_size, void* d_ws, size_t ws_size, hipStream_t stream) {
    static int grid = 0;
    if (grid == 0) {
        if (n_in != 23 || in_sizes[0] != M * DM || out_size != M * DM || ws_size < WS_END) { fprintf(stderr, "kernel_launch: shape/workspace mismatch (n_in %d, in0 %d, out %d, ws %zu)\n", n_in, n_in > 0 ? in_sizes[0] : -1, out_size, ws_size); grid = -1; return; }
        if (hipFuncSetAttribute((const void*)fwd_kernel, hipFuncAttributeMaxDynamicSharedMemorySize, LDS_BYTES) != hipSuccess) { fprintf(stderr, "kernel_launch: hipFuncSetAttribute failed\n"); grid = -1; return; }
        int per_cu = 0;
        if (hipOccupancyMaxActiveBlocksPerMultiprocessor(&per_cu, (const void*)fwd_kernel, NWAVES * 64, LDS_BYTES) != hipSuccess || per_cu < 1) fprintf(stderr, "kernel_launch: occupancy query reports %d\n", per_cu);
        (void)hipGetLastError();
        grid = 256;
    }
    if (grid < 0) return;
    if (hipMemsetAsync((char*)d_ws + WS_CTL, 0, CTL_ZERO_BYTES, stream) != hipSuccess) { fprintf(stderr, "kernel_launch: memset failed\n"); return; }
    Args a{};
    for (int i = 0; i < 23; ++i) a.in[i] = (const float*)d_in[i];
    a.out = (float*)d_out; a.ws = (unsigned char*)d_ws;
    if (MK_N_LAUNCHES == 1) { a.ph_lo = 0; a.ph_hi = N_PHASES; hipLaunchKernelGGL(fwd_kernel, dim3(grid), dim3(NWAVES * 64), LDS_BYTES, stream, a); }
    else for (int p = 0; p < N_PHASES; ++p) { a.ph_lo = p; a.ph_hi = p + 1; hipLaunchKernelGGL(fwd_kernel, dim3(grid), dim3(NWAVES * 64), LDS_BYTES, stream, a); }
    const hipError_t le = hipPeekAtLastError();
    if (le != hipSuccess) fprintf(stderr, "kernel_launch: launch failed: %s\n", hipGetErrorName(le));
}
```
